# Optimizing an MI355X kernel written in HIP

```python
import numpy as np
import jax, jax.numpy as jnp
from jax import lax

D_MODEL = 1024
BATCH = 8
SEQ = 2048
DEPTH = 2

N_MIXERS = 4
MIX_W = D_MODEL // N_MIXERS
HEAD_DIM = 64
N_Q_HEADS = MIX_W // HEAD_DIM
N_KV_HEADS = 2
Q_PER_KV = N_Q_HEADS // N_KV_HEADS
KV_W = N_KV_HEADS * HEAD_DIM
GMLP_GROUPS = 4
GMLP_CHUNK = 128
CMP_LEN = 32
CMP_STRIDE = 16
CMP_HIDDEN = 128
SEL_BLOCK = 64
SEL_TOPK = 8
N_LOCAL_BLOCKS = 2
WINDOW = 512
Q_BLOCK = 128
CONF_KERNEL = 31
SCONV_KERNEL = 3
D_FF = 4 * D_MODEL
NSA_GATE_W = N_Q_HEADS * 3
IN_WIDTHS = (MIX_W, MIX_W, MIX_W, KV_W, KV_W, KV_W, KV_W, KV_W, KV_W, NSA_GATE_W, MIX_W, MIX_W, MIX_W, MIX_W, MIX_W)
IN_COLS = sum(IN_WIDTHS)
NEG_INF = -1e30

kernel_name = "hybrid_gated_nsa_gmlp_conv_block"


def _rms(x, g, eps=1e-6):
    xf = x.astype(jnp.float32)
    y = xf * lax.rsqrt(jnp.mean(xf * xf, axis=-1, keepdims=True) + eps)
    return (y * g.astype(jnp.float32)).astype(x.dtype)


def _layernorm(x, g, b, eps=1e-5):
    xf = x.astype(jnp.float32)
    mu = jnp.mean(xf, axis=-1, keepdims=True)
    var = jnp.mean(jnp.square(xf - mu), axis=-1, keepdims=True)
    return ((xf - mu) * lax.rsqrt(var + eps) * g.astype(jnp.float32) + b.astype(jnp.float32)).astype(x.dtype)


def _causal_depthwise_conv(x, w):
    k = w.shape[0]
    return lax.conv_general_dilated(x, w[:, None, :].astype(x.dtype), window_strides=(1,),
                                    padding=[(k - 1, 0)], dimension_numbers=('NWC', 'WIO', 'NWC'),
                                    feature_group_count=x.shape[-1])


def _gmlp_spatial_gate(u, v, ln_g, ln_b, ws, bs):
    B, S, _ = v.shape
    nc = S // GMLP_CHUNK
    v = _layernorm(v, ln_g, ln_b).reshape(B, nc, GMLP_CHUNK, GMLP_GROUPS, MIX_W // GMLP_GROUPS)
    mask = np.tril(np.ones((GMLP_CHUNK, GMLP_CHUNK), dtype=bool))
    wsm = jnp.where(mask, ws, 0).astype(v.dtype)
    mixed = jnp.einsum('gts,bnsgc->bntgc', wsm, v) + bs.T[None, None, :, :, None].astype(v.dtype)
    return u * mixed.reshape(B, S, MIX_W)


def _overlap_matrix(n_cmp, n_sel):
    cs = np.arange(n_cmp) * CMP_STRIDE
    ce = cs + CMP_LEN
    ss = np.arange(n_sel) * SEL_BLOCK
    se = ss + SEL_BLOCK
    return ((cs[:, None] < se[None, :]) & (ce[:, None] > ss[None, :])).astype(np.float32)


def _nsa(q, kc, vc, ks, vs, kw, vw, gate_logits, q_g, k_g, cmp_pe, cmp_w1, cmp_w2):
    B, S, _ = q.shape
    T = Q_BLOCK
    nqb = S // T
    pos = jnp.arange(S)
    scale = HEAD_DIM ** -0.5
    heads = lambda t: t.reshape(B, S, N_KV_HEADS, HEAD_DIM)
    q = _rms(q.reshape(B, S, N_KV_HEADS, Q_PER_KV, HEAD_DIM), q_g)

    n_cmp = (S - CMP_LEN) // CMP_STRIDE + 1
    cmp_idx = np.arange(n_cmp)[:, None] * CMP_STRIDE + np.arange(CMP_LEN)[None, :]

    def compress(t, pe, w1, w2):
        blk = jnp.take(heads(t), cmp_idx, axis=1) + pe[None, None, :, None, :]
        blk = jnp.swapaxes(blk, 2, 3).reshape(B, n_cmp, N_KV_HEADS, CMP_LEN * HEAD_DIM)
        hid = jax.nn.gelu(jnp.einsum('bnhf,fe->bnhe', blk, w1))
        return jnp.einsum('bnhe,ed->bnhd', hid, w2)

    k_cmp = _rms(compress(kc, cmp_pe[0], cmp_w1[0], cmp_w2[0]), k_g[0])
    v_cmp = compress(vc, cmp_pe[1], cmp_w1[1], cmp_w2[1])
    cmp_valid = cmp_idx[:, -1][None, :] <= np.arange(S)[:, None]
    s = jnp.einsum('bshgd,bnhd->bhgsn', q, k_cmp).astype(jnp.float32) * scale
    p_cmp = jnp.where(cmp_valid, jax.nn.softmax(jnp.where(cmp_valid, s, NEG_INF), axis=-1), 0.0)
    o_cmp = jnp.einsum('bhgsn,bnhd->bshgd', p_cmp.astype(v_cmp.dtype), v_cmp)

    n_sel = S // SEL_BLOCK
    k_top = min(SEL_TOPK, n_sel)
    p_slc = jnp.einsum('bhgsn,nj->bhsj', p_cmp, jnp.asarray(_overlap_matrix(n_cmp, n_sel)))
    blk = np.arange(n_sel)[None, :]
    cur = (np.arange(S) // SEL_BLOCK)[:, None]
    forced = (blk == 0) | ((cur - blk >= 0) & (cur - blk < N_LOCAL_BLOCKS))
    causal = blk <= cur
    score = jnp.where(forced, jnp.inf, jnp.where(causal, p_slc, -jnp.inf))
    sel_idx = lax.top_k(score, k_top)[1]

    ks_h = jnp.swapaxes(_rms(heads(ks), k_g[1]), 1, 2)
    vs_h = jnp.swapaxes(heads(vs), 1, 2)
    gather = jax.vmap(jax.vmap(lambda a, i: a[i]))
    tok_off = jnp.arange(SEL_BLOCK)

    def sel_block(args):
        qb, ib, pb = args
        tok = (ib[..., None] * SEL_BLOCK + tok_off).reshape(B, N_KV_HEADS, T, k_top * SEL_BLOCK)
        flat = tok.reshape(B, N_KV_HEADS, -1)
        kg = gather(ks_h, flat).reshape(B, N_KV_HEADS, T, k_top * SEL_BLOCK, HEAD_DIM)
        vg = gather(vs_h, flat).reshape(B, N_KV_HEADS, T, k_top * SEL_BLOCK, HEAD_DIM)
        sb = jnp.einsum('bthgd,bhtkd->bhgtk', qb, kg).astype(jnp.float32) * scale
        m = (tok <= pb[:, None])[:, :, None]
        pr = jax.nn.softmax(jnp.where(m, sb, NEG_INF), axis=-1).astype(vg.dtype)
        return jnp.einsum('bhgtk,bhtkd->bthgd', pr, vg)

    q_blocks = jnp.moveaxis(q.reshape(B, nqb, T, N_KV_HEADS, Q_PER_KV, HEAD_DIM), 1, 0)
    i_blocks = jnp.moveaxis(sel_idx.reshape(B, N_KV_HEADS, nqb, T, k_top), 2, 0)
    p_blocks = pos.reshape(nqb, T)
    o_sel = jnp.moveaxis(lax.map(sel_block, (q_blocks, i_blocks, p_blocks)), 0, 1)
    o_sel = o_sel.reshape(B, S, N_KV_HEADS, Q_PER_KV, HEAD_DIM)

    kw_h = _rms(heads(kw), k_g[2])
    vw_h = heads(vw)
    win_idx = np.arange(nqb)[:, None] * T + np.arange(WINDOW + T)[None, :]
    kpos = (win_idx - WINDOW)[:, None, :]
    qpos = np.arange(S).reshape(nqb, T)[:, :, None]
    wmask = (kpos <= qpos) & (kpos > qpos - WINDOW) & (kpos >= 0)
    pad = ((0, 0), (WINDOW, 0), (0, 0), (0, 0))
    kb = jnp.take(jnp.pad(kw_h, pad), win_idx, axis=1)
    vb = jnp.take(jnp.pad(vw_h, pad), win_idx, axis=1)
    qb = q.reshape(B, nqb, T, N_KV_HEADS, Q_PER_KV, HEAD_DIM)
    sw = jnp.einsum('bnthgd,bnmhd->bnhgtm', qb, kb).astype(jnp.float32) * scale
    pw = jax.nn.softmax(jnp.where(wmask[:, None, None], sw, NEG_INF), axis=-1).astype(vb.dtype)
    o_win = jnp.einsum('bnhgtm,bnmhd->bnthgd', pw, vb).reshape(B, S, N_KV_HEADS, Q_PER_KV, HEAD_DIM)

    g = jax.nn.sigmoid(gate_logits.reshape(B, S, N_KV_HEADS, Q_PER_KV, 3))
    o = g[..., 0:1] * o_cmp + g[..., 1:2] * o_sel + g[..., 2:3] * o_win
    return o.reshape(B, S, MIX_W)


def setup_inputs(seed: int = 0) -> dict:
    key = jax.random.key(seed)
    ks = jax.random.split(key, 26)
    L = DEPTH
    nrm = lambda k, shape, sc: jax.random.normal(k, shape, jnp.float32) * sc
    res_sc = (2.0 * DEPTH) ** -0.5
    return {
        "x": nrm(ks[0], (BATCH, SEQ, D_MODEL), 1.0),
        "norm1_g": 1.0 + nrm(ks[1], (L, D_MODEL), 0.02),
        "w_in": nrm(ks[2], (L, D_MODEL, IN_COLS), D_MODEL ** -0.5),
        "gmlp_ln_g": 1.0 + nrm(ks[3], (L, MIX_W), 0.02),
        "gmlp_ln_b": nrm(ks[4], (L, MIX_W), 0.02),
        "gmlp_ws": nrm(ks[5], (L, GMLP_GROUPS, GMLP_CHUNK, GMLP_CHUNK), GMLP_CHUNK ** -0.5),
        "gmlp_bs": 1.0 + nrm(ks[6], (L, GMLP_GROUPS, GMLP_CHUNK), 0.02),
        "nsa_q_norm_g": 1.0 + nrm(ks[7], (L, HEAD_DIM), 0.02),
        "nsa_k_norm_g": 1.0 + nrm(ks[8], (L, 3, HEAD_DIM), 0.02),
        "nsa_cmp_pe": nrm(ks[9], (L, 2, CMP_LEN, HEAD_DIM), 0.02),
        "nsa_cmp_w1": nrm(ks[10], (L, 2, CMP_LEN * HEAD_DIM, CMP_HIDDEN), (CMP_LEN * HEAD_DIM) ** -0.5),
        "nsa_cmp_w2": nrm(ks[11], (L, 2, CMP_HIDDEN, HEAD_DIM), CMP_HIDDEN ** -0.5),
        "conf_conv_w": nrm(ks[12], (L, CONF_KERNEL, MIX_W), CONF_KERNEL ** -0.5),
        "conf_conv_b": nrm(ks[13], (L, MIX_W), 0.02),
        "conf_ln_g": 1.0 + nrm(ks[14], (L, MIX_W), 0.02),
        "conf_ln_b": nrm(ks[15], (L, MIX_W), 0.02),
        "sconv_w": nrm(ks[16], (L, SCONV_KERNEL, MIX_W), SCONV_KERNEL ** -0.5),
        "w_branch": nrm(ks[17], (L, N_MIXERS, MIX_W, D_MODEL), MIX_W ** -0.5),
        "w_gate": nrm(ks[18], (L, D_MODEL, N_MIXERS * D_MODEL), D_MODEL ** -0.5),
        "b_gate": nrm(ks[19], (L, N_MIXERS * D_MODEL), 0.02),
        "w_out": nrm(ks[20], (L, D_MODEL, D_MODEL), D_MODEL ** -0.5 * res_sc),
        "norm2_g": 1.0 + nrm(ks[21], (L, D_MODEL), 0.02),
        "w_mlp1": nrm(ks[22], (L, D_MODEL, D_FF), D_MODEL ** -0.5),
        "w_mlp2": nrm(ks[23], (L, D_FF, D_MODEL), D_FF ** -0.5 * res_sc),
    }


def reference(x, norm1_g, w_in, gmlp_ln_g, gmlp_ln_b, gmlp_ws, gmlp_bs, nsa_q_norm_g, nsa_k_norm_g,
              nsa_cmp_pe, nsa_cmp_w1, nsa_cmp_w2, conf_conv_w, conf_conv_b, conf_ln_g, conf_ln_b,
              sconv_w, w_branch, w_gate, b_gate, w_out, norm2_g, w_mlp1, w_mlp2):
    B, S, D = x.shape
    split_points = np.cumsum(IN_WIDTHS)[:-1].tolist()
    for l in range(DEPTH):
        xn = _rms(x, norm1_g[l])
        (gu, gv, q, kc, vc, ks_, vs_, kw, vw, ng, ca, cb, sB, sC, sh) = jnp.split(
            jnp.einsum('bsd,de->bse', xn, w_in[l]), split_points, axis=-1)
        y_a = _gmlp_spatial_gate(jax.nn.gelu(gu), jax.nn.gelu(gv), gmlp_ln_g[l], gmlp_ln_b[l], gmlp_ws[l], gmlp_bs[l])
        y_b = _nsa(q, kc, vc, ks_, vs_, kw, vw, ng, nsa_q_norm_g[l], nsa_k_norm_g[l],
                   nsa_cmp_pe[l], nsa_cmp_w1[l], nsa_cmp_w2[l])
        z = ca * jax.nn.sigmoid(cb)
        z = _causal_depthwise_conv(z, conf_conv_w[l]) + conf_conv_b[l]
        y_c = jax.nn.silu(_layernorm(z, conf_ln_g[l], conf_ln_b[l]))
        y_d = sB * _causal_depthwise_conv(sC * sh, sconv_w[l])
        ys = jnp.stack([y_a, y_b, y_c, y_d], axis=2)
        proj = jnp.einsum('bsnc,ncd->bsnd', ys, w_branch[l])
        gates = jax.nn.sigmoid(jnp.einsum('bsd,de->bse', xn, w_gate[l]) + b_gate[l]).reshape(B, S, N_MIXERS, D)
        mixed = jnp.sum(gates * proj, axis=2)
        x = x + jnp.einsum('bsd,de->bse', mixed, w_out[l])
        hn = _rms(x, norm2_g[l])
        hid = jnp.square(jax.nn.relu(jnp.einsum('bsd,df->bsf', hn, w_mlp1[l])))
        x = x + jnp.einsum('bsf,fd->bsd', hid, w_mlp2[l])
    return x
```

```cpp
#include <hip/hip_runtime.h>
#include <hip/hip_cooperative_groups.h>
#include <cstdio>
namespace cg = cooperative_groups;

#ifndef MULTI_LAUNCH
#define MULTI_LAUNCH 1
#endif

#define DEVI __device__ __forceinline__
typedef unsigned short bfu;
using bf16x8 = __attribute__((ext_vector_type(8))) short;
using bf16x4 = __attribute__((ext_vector_type(4))) short;
using f32x4  = __attribute__((ext_vector_type(4))) float;

constexpr int NTOK = 16384, SEQ = 2048;
constexpr int LDP = 2944;
constexpr int C_GU = 0, C_GV = 256, C_Q = 512, C_KC = 768, C_VC = 896, C_KS = 1024, C_VS = 1152, C_KW = 1280,
              C_VW = 1408, C_CA = 1536, C_CB = 1792, C_SB = 2048, C_SC = 2304, C_SH = 2560, C_NG = 2816;
constexpr int LDS_BYTES = 73728;
constexpr int LS = 72;

constexpr size_t OFF_WIN = 0;
constexpr size_t OFF_WGATE = OFF_WIN + 6029312;
constexpr size_t OFF_WBR = OFF_WGATE + 8388608;
constexpr size_t OFF_WOUT = OFF_WBR + 2097152;
constexpr size_t OFF_WM1 = OFF_WOUT + 2097152;
constexpr size_t OFF_WM2 = OFF_WM1 + 8388608;
constexpr size_t OFF_CW1 = OFF_WM2 + 8388608;
constexpr size_t OFF_CW2 = OFF_CW1 + 1048576;
constexpr size_t OFF_CBIAS = OFF_CW2 + 32768;
constexpr size_t OFF_XN = OFF_CBIAS + 4096;
constexpr size_t OFF_PROJ = OFF_XN + 33554432;
constexpr size_t OFF_Y = OFF_PROJ + 96468992;
constexpr size_t OFF_MIX = OFF_Y + 33554432;
constexpr size_t OFF_HID = OFF_PROJ;
constexpr size_t OFF_KCMP = OFF_MIX + 33554432;
constexpr size_t OFF_VCT = OFF_KCMP + 262144;
constexpr size_t OFF_VST = OFF_VCT + 262144;
constexpr size_t OFF_VWT = OFF_VST + 4194304;
constexpr size_t OFF_CHID = OFF_VWT + 4194304;
constexpr size_t WS_TOTAL = OFF_CHID + 1048576;

struct Params {
  const float* in[24];
  float* out;
  char* ws;
};

DEVI int get_tid() { int t = threadIdx.x; asm volatile("" : "+v"(t)); return t; }
DEVI bfu f2bf(float f) {
  unsigned u = __float_as_uint(f);
  u += 0x7fffu + ((u >> 16) & 1u);
  return (bfu)(u >> 16);
}
DEVI float bf2f(bfu h) { return __uint_as_float(((unsigned)h) << 16); }
DEVI unsigned pack2(float a, float b) { return (unsigned)f2bf(a) | ((unsigned)f2bf(b) << 16); }
DEVI float lo2f(unsigned u) { return __uint_as_float(u << 16); }
DEVI float hi2f(unsigned u) { return __uint_as_float(u & 0xffff0000u); }
DEVI float sigmoidf_(float x) { return 1.f / (1.f + __expf(-x)); }
DEVI float gelu_f(float x) {
  float u = 0.7978845608028654f * (x + 0.044715f * x * x * x);
  return x / (1.f + __expf(-2.f * u));
}
DEVI void store_bf4(bfu* p, f32x4 v) {
  uint2 u; u.x = pack2(v[0], v[1]); u.y = pack2(v[2], v[3]);
  *(uint2*)p = u;
}
DEVI float wave_sum(float v) {
#pragma unroll
  for (int o = 32; o >= 1; o >>= 1) v += __shfl_xor(v, o);
  return v;
}

template <int BN, typename AF>
DEVI void gemm_core(f32x4 (&acc)[BN / 32][4], AF arow, long a_kstride, const bfu* __restrict__ Bt, int ldb, int nkt,
                    bfu* lds) {
  constexpr int NI = BN / 32;
  constexpr int BCH = BN * 8 / 256;
  bfu* As = lds;
  bfu* Bs = lds + 2 * 128 * LS;
  const int tid = get_tid(), lane = tid & 63, wid = tid >> 6, wm = wid >> 1, wn = wid & 1;
  const int fr = lane & 15, fq = lane >> 4;
  const bfu* ap[4];
  const bfu* bp[BCH];
#pragma unroll
  for (int i = 0; i < 4; ++i) { int id = tid + 256 * i; ap[i] = arow(id >> 3) + (id & 7) * 8; }
#pragma unroll
  for (int i = 0; i < BCH; ++i) { int id = tid + 256 * i; bp[i] = Bt + (long)(id >> 3) * ldb + (id & 7) * 8; }
  uint4 ra0, ra1, ra2, ra3, rb0, rb1, rb2 = make_uint4(0, 0, 0, 0), rb3 = make_uint4(0, 0, 0, 0);
#define G_LOAD(KT)                                                        \
  do {                                                                    \
    ra0 = *(const uint4*)(ap[0] + (long)(KT) * a_kstride);                \
    ra1 = *(const uint4*)(ap[1] + (long)(KT) * a_kstride);                \
    ra2 = *(const uint4*)(ap[2] + (long)(KT) * a_kstride);                \
    ra3 = *(const uint4*)(ap[3] + (long)(KT) * a_kstride);                \
    rb0 = *(const uint4*)(bp[0] + (KT) * 64);                             \
    rb1 = *(const uint4*)(bp[1] + (KT) * 64);                             \
    if constexpr (BCH == 4) {                                             \
      rb2 = *(const uint4*)(bp[2] + (KT) * 64);                           \
      rb3 = *(const uint4*)(bp[3] + (KT) * 64);                           \
    }                                                                     \
  } while (0)
#define L_STORE(AW, BW)                                                   \
  do {                                                                    \
    *(uint4*)((AW) + ((tid) >> 3) * LS + (tid & 7) * 8) = ra0;            \
    *(uint4*)((AW) + ((tid + 256) >> 3) * LS + (tid & 7) * 8) = ra1;      \
    *(uint4*)((AW) + ((tid + 512) >> 3) * LS + (tid & 7) * 8) = ra2;      \
    *(uint4*)((AW) + ((tid + 768) >> 3) * LS + (tid & 7) * 8) = ra3;      \
    *(uint4*)((BW) + ((tid) >> 3) * LS + (tid & 7) * 8) = rb0;            \
    *(uint4*)((BW) + ((tid + 256) >> 3) * LS + (tid & 7) * 8) = rb1;      \
    if constexpr (BCH == 4) {                                             \
      *(uint4*)((BW) + ((tid + 512) >> 3) * LS + (tid & 7) * 8) = rb2;    \
      *(uint4*)((BW) + ((tid + 768) >> 3) * LS + (tid & 7) * 8) = rb3;    \
    }                                                                     \
  } while (0)
  G_LOAD(0);
  L_STORE(As, Bs);
  __syncthreads();
#pragma unroll 1
  for (int kt = 0; kt < nkt; ++kt) {
    const int buf = kt & 1;
    const bool more = (kt + 1 < nkt);
    if (more) G_LOAD(kt + 1);
    const bfu* Ab = As + buf * 128 * LS;
    const bfu* Bb = Bs + buf * BN * LS;
#pragma unroll
    for (int ks = 0; ks < 2; ++ks) {
      bf16x8 tf[4], wf[NI];
#pragma unroll
      for (int mi = 0; mi < 4; ++mi) tf[mi] = *(const bf16x8*)(Ab + (wm * 64 + mi * 16 + fr) * LS + ks * 32 + fq * 8);
#pragma unroll
      for (int ni = 0; ni < NI; ++ni) wf[ni] = *(const bf16x8*)(Bb + (wn * (BN / 2) + ni * 16 + fr) * LS + ks * 32 + fq * 8);
#pragma unroll
      for (int ni = 0; ni < NI; ++ni)
#pragma unroll
        for (int mi = 0; mi < 4; ++mi)
          acc[ni][mi] = __builtin_amdgcn_mfma_f32_16x16x32_bf16(wf[ni], tf[mi], acc[ni][mi], 0, 0, 0);
    }
    if (more) {
      bfu* Aw = As + (buf ^ 1) * 128 * LS;
      bfu* Bw = Bs + (buf ^ 1) * BN * LS;
      L_STORE(Aw, Bw);
    }
    __syncthreads();
  }
#undef G_LOAD
#undef L_STORE
}

template <int NI>
DEVI void zero_acc(f32x4 (&acc)[NI][4]) {
#pragma unroll
  for (int a = 0; a < NI; ++a)
#pragma unroll
    for (int b = 0; b < 4; ++b) acc[a][b] = f32x4{0.f, 0.f, 0.f, 0.f};
}

DEVI void cvt_tile(const float* __restrict__ src, int ld_src, int col0, int valid, bfu* __restrict__ dst, int ld_dst,
                   char* lds_raw) {
  float* tile = (float*)lds_raw;
  const int tid = get_tid();
  __syncthreads();
#pragma unroll
  for (int i = 0; i < 4; ++i) {
    int id = tid + 256 * i;
    int row = id >> 4, c4 = id & 15;
    float4 v = make_float4(0.f, 0.f, 0.f, 0.f);
    if (c4 * 4 < valid) v = *(const float4*)(src + (long)row * ld_src + col0 + c4 * 4);
    float* t = tile + row * 65 + c4 * 4;
    t[0] = v.x; t[1] = v.y; t[2] = v.z; t[3] = v.w;
  }
  __syncthreads();
#pragma unroll
  for (int i = 0; i < 2; ++i) {
    int id = tid + 256 * i;
    int n = id & 63, kc = id >> 6;
    uint4 o;
    o.x = pack2(tile[(kc * 8 + 0) * 65 + n], tile[(kc * 8 + 1) * 65 + n]);
    o.y = pack2(tile[(kc * 8 + 2) * 65 + n], tile[(kc * 8 + 3) * 65 + n]);
    o.z = pack2(tile[(kc * 8 + 4) * 65 + n], tile[(kc * 8 + 5) * 65 + n]);
    o.w = pack2(tile[(kc * 8 + 6) * 65 + n], tile[(kc * 8 + 7) * 65 + n]);
    *(uint4*)(dst + (long)n * ld_dst + kc * 8) = o;
  }
}

constexpr int P1_CVT = 4452;
constexpr int P1_BIAS = 2;
constexpr int P1_RMS = 1024;
constexpr int P1_ITEMS = P1_CVT + P1_BIAS + P1_RMS;

DEVI void rms_rows(const float* __restrict__ x, const float* __restrict__ g, bfu* __restrict__ dst, int item) {
  const int lane = get_tid() & 63, wid = get_tid() >> 6;
#pragma unroll
  for (int r = 0; r < 4; ++r) {
    long row = (long)item * 16 + wid * 4 + r;
    const float4* xr = (const float4*)(x + row * 1024);
    float4 v[4];
    float ss = 0.f;
#pragma unroll
    for (int i = 0; i < 4; ++i) {
      v[i] = xr[lane + 64 * i];
      ss += v[i].x * v[i].x + v[i].y * v[i].y + v[i].z * v[i].z + v[i].w * v[i].w;
    }
    ss = wave_sum(ss);
    float rstd = rsqrtf(ss * (1.f / 1024.f) + 1e-6f);
#pragma unroll
    for (int i = 0; i < 4; ++i) {
      float4 gg = ((const float4*)g)[lane + 64 * i];
      uint2 o;
      o.x = pack2(v[i].x * rstd * gg.x, v[i].y * rstd * gg.y);
      o.y = pack2(v[i].z * rstd * gg.z, v[i].w * rstd * gg.w);
      *(uint2*)(dst + row * 1024 + (lane + 64 * i) * 4) = o;
    }
  }
}

DEVI void phase1(const Params& p, int l, char* lds) {
  char* ws = p.ws;
  const float* xin = (l == 0) ? p.in[0] : p.out;
  for (int item = blockIdx.x; item < P1_ITEMS; item += gridDim.x) {
    int i = item;
    if (i < P1_CVT) {
      if (i < 736) {
        int kt = i / 46, nt = i % 46;
        int col0, valid;
        if (nt < 24) { col0 = nt * 64; valid = 64; }
        else if (nt < 44) { col0 = nt * 64 + 12; valid = 64; }
        else if (nt == 44) { col0 = 1536; valid = 12; }
        else { col0 = 0; valid = 0; }
        cvt_tile(p.in[2] + (long)l * 1024 * 2828 + (long)kt * 64 * 2828, 2828, col0, valid,
                 (bfu*)(ws + OFF_WIN) + (long)nt * 64 * 1024 + kt * 64, 1024, lds);
        continue;
      }
      i -= 736;
      if (i < 1024) {
        int kt = i / 64, nt = i % 64;
        cvt_tile(p.in[18] + (long)l * 1024 * 4096 + (long)kt * 64 * 4096, 4096, nt * 64, 64,
                 (bfu*)(ws + OFF_WGATE) + (long)nt * 64 * 1024 + kt * 64, 1024, lds);
        continue;
      }
      i -= 1024;
      if (i < 256) {
        int bb = i / 64, r = i % 64, kt = r / 16, nt = r % 16;
        cvt_tile(p.in[17] + ((long)(l * 4 + bb) * 256 + kt * 64) * 1024, 1024, nt * 64, 64,
                 (bfu*)(ws + OFF_WBR) + ((long)bb * 1024 + nt * 64) * 256 + kt * 64, 256, lds);
        continue;
      }
      i -= 256;
      if (i < 256) {
        int kt = i / 16, nt = i % 16;
        cvt_tile(p.in[20] + (long)l * 1024 * 1024 + (long)kt * 64 * 1024, 1024, nt * 64, 64,
                 (bfu*)(ws + OFF_WOUT) + (long)nt * 64 * 1024 + kt * 64, 1024, lds);
        continue;
      }
      i -= 256;
      if (i < 1024) {
        int kt = i / 64, nt = i % 64;
        cvt_tile(p.in[22] + (long)l * 1024 * 4096 + (long)kt * 64 * 4096, 4096, nt * 64, 64,
                 (bfu*)(ws + OFF_WM1) + (long)nt * 64 * 1024 + kt * 64, 1024, lds);
        continue;
      }
      i -= 1024;
      if (i < 1024) {
        int kt = i / 16, nt = i % 16;
        cvt_tile(p.in[23] + (long)l * 4096 * 1024 + (long)kt * 64 * 1024, 1024, nt * 64, 64,
                 (bfu*)(ws + OFF_WM2) + (long)nt * 64 * 4096 + kt * 64, 4096, lds);
        continue;
      }
      i -= 1024;
      if (i < 128) {
        int kv = i / 64, r = i % 64, kt = r / 2, nt = r % 2;
        cvt_tile(p.in[10] + ((long)(l * 2 + kv) * 2048 + kt * 64) * 128, 128, nt * 64, 64,
                 (bfu*)(ws + OFF_CW1) + ((long)kv * 128 + nt * 64) * 2048 + kt * 64, 2048, lds);
        continue;
      }
      i -= 128;
      {
        int kv = i / 2, kt = i % 2;
        cvt_tile(p.in[11] + ((long)(l * 2 + kv) * 128 + kt * 64) * 64, 64, 0, 64,
                 (bfu*)(ws + OFF_CW2) + ((long)kv * 64) * 128 + kt * 64, 128, lds);
        continue;
      }
    }
    i -= P1_CVT;
    if (i < P1_BIAS) {
      int kv = i;
      const float* pe = p.in[9] + (long)(l * 2 + kv) * 2048;
      const float* w1 = p.in[10] + (long)(l * 2 + kv) * 2048 * 128;
      int e = get_tid() & 127, half = get_tid() >> 7;
      float a = 0.f;
      for (int f = half * 1024; f < half * 1024 + 1024; ++f) a += pe[f] * w1[(long)f * 128 + e];
      float* red = (float*)lds;
      __syncthreads();
      red[get_tid()] = a;
      __syncthreads();
      if (get_tid() < 128) ((float*)(ws + OFF_CBIAS))[kv * 128 + e] = red[e] + red[128 + e];
      continue;
    }
    i -= P1_BIAS;
    rms_rows(xin, p.in[1] + l * 1024, (bfu*)(ws + OFF_XN), i);
  }
}

DEVI void phase2(const Params& p, int l, char* lds) {
  const bfu* xn = (const bfu*)(p.ws + OFF_XN);
  const bfu* wT = (const bfu*)(p.ws + OFF_WIN);
  bfu* proj = (bfu*)(p.ws + OFF_PROJ);
  const int lane = get_tid() & 63, wid = get_tid() >> 6, wm = wid >> 1, wn = wid & 1, fr = lane & 15, fq = lane >> 4;
  for (int t = blockIdx.x; t < 128 * 23; t += gridDim.x) {
    int mt = t / 23, nt = t % 23;
    int m0 = mt * 128, n0 = nt * 128;
    f32x4 acc[4][4];
    zero_acc<4>(acc);
    gemm_core<128>(acc, [&](int r) { return xn + (long)(m0 + r) * 1024; }, 64, wT + (long)n0 * 1024, 1024, 16, (bfu*)lds);
    const bool do_gelu = (n0 < 512);
#pragma unroll
    for (int ni = 0; ni < 4; ++ni)
#pragma unroll
      for (int mi = 0; mi < 4; ++mi) {
        f32x4 v = acc[ni][mi];
        if (do_gelu) { v[0] = gelu_f(v[0]); v[1] = gelu_f(v[1]); v[2] = gelu_f(v[2]); v[3] = gelu_f(v[3]); }
        int n = n0 + wn * 64 + ni * 16 + fq * 4;
        int m = m0 + wm * 64 + mi * 16 + fr;
        store_bf4(proj + (long)m * LDP + n, v);
      }
  }
}

DEVI void compress_item(const Params& p, int l, int ci, char* lds) {
  const bfu* proj = (const bfu*)(p.ws + OFF_PROJ);
  const int kv = ci >> 4, bh = ci & 15, b = bh >> 1, h = bh & 1;
  const int lane = get_tid() & 63, wid = get_tid() >> 6, wm = wid >> 1, wn = wid & 1, fr = lane & 15, fq = lane >> 4;
  bfu* chid = (bfu*)(p.ws + OFF_CHID) + (long)ci * 128 * 128;
  const float* bias = (const float*)(p.ws + OFF_CBIAS) + kv * 128;
  {
    f32x4 acc[4][4];
    zero_acc<4>(acc);
    const bfu* abase = proj + (long)(b * SEQ) * LDP + (kv ? C_VC : C_KC) + h * 64;
    gemm_core<128>(acc, [&](int r) { int n = r < 126 ? r : 126; return abase + (long)(n * 16) * LDP; }, (long)LDP,
                   (const bfu*)(p.ws + OFF_CW1) + (long)kv * 128 * 2048, 2048, 32, (bfu*)lds);
#pragma unroll
    for (int ni = 0; ni < 4; ++ni)
#pragma unroll
      for (int mi = 0; mi < 4; ++mi) {
        int e = wn * 64 + ni * 16 + fq * 4;
        int m = wm * 64 + mi * 16 + fr;
        f32x4 v = acc[ni][mi];
        float4 bb = *(const float4*)(bias + e);
        v[0] = gelu_f(v[0] + bb.x); v[1] = gelu_f(v[1] + bb.y); v[2] = gelu_f(v[2] + bb.z); v[3] = gelu_f(v[3] + bb.w);
        store_bf4(chid + m * 128 + e, v);
      }
  }
  __threadfence();
  __syncthreads();
  float* outs = (float*)lds;
  {
    f32x4 acc2[2][4];
    zero_acc<2>(acc2);
    gemm_core<64>(acc2, [&](int r) { return (const bfu*)chid + r * 128; }, 64,
                  (const bfu*)(p.ws + OFF_CW2) + (long)kv * 64 * 128, 128, 2, (bfu*)lds);
#pragma unroll
    for (int ni = 0; ni < 2; ++ni)
#pragma unroll
      for (int mi = 0; mi < 4; ++mi) {
        int d = wn * 32 + ni * 16 + fq * 4;
        int m = wm * 64 + mi * 16 + fr;
#pragma unroll
        for (int j = 0; j < 4; ++j) outs[m * 65 + d + j] = acc2[ni][mi][j];
      }
  }
  __syncthreads();
  if (kv == 0) {
    if (get_tid() < 128) {
      int n = get_tid();
      float ss = 0.f;
      for (int d = 0; d < 64; ++d) { float v = outs[n * 65 + d]; ss += v * v; }
      float rstd = rsqrtf(ss * (1.f / 64.f) + 1e-6f);
      const float* kg = p.in[8] + (long)(l * 3 + 0) * 64;
      bfu* dst = (bfu*)(p.ws + OFF_KCMP) + ((long)(b * 2 + h) * 128 + n) * 64;
      for (int d = 0; d < 64; d += 2)
        *(unsigned*)(dst + d) = pack2(outs[n * 65 + d] * rstd * kg[d], outs[n * 65 + d + 1] * rstd * kg[d + 1]);
    }
  } else {
    bfu* dst = (bfu*)(p.ws + OFF_VCT) + (long)(b * 2 + h) * 64 * 128;
    for (int id = get_tid(); id < 64 * 128; id += 256) {
      int d = id >> 7, n = id & 127;
      dst[d * 128 + n] = f2bf(outs[n * 65 + d]);
    }
  }
  __syncthreads();
}

DEVI void gmlp_item(const Params& p, int l, int idx, char* lds) {
  const bfu* proj = (const bfu*)(p.ws + OFF_PROJ);
  bfu* y = (bfu*)(p.ws + OFF_Y);
  const int g = idx & 3, chunk = (idx >> 2) & 15, b = idx >> 6;
  const long tok0 = (long)b * SEQ + chunk * 128;
  const int tid = get_tid(), lane = tid & 63;
  const int wid = __builtin_amdgcn_readfirstlane(tid >> 6);
  float* vln = (float*)lds;
  float* stats = vln + 128 * 64;
  __syncthreads();
  for (int i = 0; i < 32; ++i) {
    int t = wid + 4 * i;
    uint2 u = *(const uint2*)(proj + (tok0 + t) * LDP + C_GV + lane * 4);
    float a0 = lo2f(u.x), a1 = hi2f(u.x), a2 = lo2f(u.y), a3 = hi2f(u.y);
    float mean = wave_sum(a0 + a1 + a2 + a3) * (1.f / 256.f);
    float d0 = a0 - mean, d1 = a1 - mean, d2 = a2 - mean, d3 = a3 - mean;
    float var = wave_sum(d0 * d0 + d1 * d1 + d2 * d2 + d3 * d3) * (1.f / 256.f);
    if (lane == 0) { stats[t * 2] = mean; stats[t * 2 + 1] = rsqrtf(var + 1e-5f); }
  }
  __syncthreads();
  const float* lg = p.in[3] + l * 256 + g * 64;
  const float* lb = p.in[4] + l * 256 + g * 64;
  for (int i = 0; i < 8; ++i) {
    int id = tid + 256 * i;
    int t = id >> 4, c4 = (id & 15) * 4;
    uint2 u = *(const uint2*)(proj + (tok0 + t) * LDP + C_GV + g * 64 + c4);
    float mean = stats[t * 2], rstd = stats[t * 2 + 1];
    float4 gg = *(const float4*)(lg + c4), bb = *(const float4*)(lb + c4);
    float4 o;
    o.x = (lo2f(u.x) - mean) * rstd * gg.x + bb.x;
    o.y = (hi2f(u.x) - mean) * rstd * gg.y + bb.y;
    o.z = (lo2f(u.y) - mean) * rstd * gg.z + bb.z;
    o.w = (hi2f(u.y) - mean) * rstd * gg.w + bb.w;
    *(float4*)(vln + t * 64 + c4) = o;
  }
  __syncthreads();
  const int c = lane;
  const float* wsg = p.in[5] + (long)(l * 4 + g) * 128 * 128;
  const float* bsg = p.in[6] + (long)(l * 4 + g) * 128;
  for (int i = 0; i < 32; ++i) {
    int t = wid + 4 * i;
    const float4* wr = (const float4*)(wsg + t * 128);
    float acc = 0.f;
    int n4 = (t >> 2) + 1;
    for (int s4 = 0; s4 < n4; ++s4) {
      float4 w = wr[s4];
      int s = s4 * 4;
      if (s + 1 > t) w.y = 0.f;
      if (s + 2 > t) w.z = 0.f;
      if (s + 3 > t) w.w = 0.f;
      acc += w.x * vln[(s + 0) * 64 + c] + w.y * vln[(s + 1) * 64 + c] + w.z * vln[(s + 2) * 64 + c] + w.w * vln[(s + 3) * 64 + c];
    }
    float u = bf2f(proj[(tok0 + t) * LDP + C_GU + g * 64 + c]);
    y[(tok0 + t) * 1024 + g * 64 + c] = f2bf(u * (acc + bsg[t]));
  }
}

DEVI void conf_item(const Params& p, int l, int idx, char* lds) {
  const bfu* proj = (const bfu*)(p.ws + OFF_PROJ);
  bfu* y = (bfu*)(p.ws + OFF_Y);
  const int b = idx >> 6, tile = idx & 63;
  const int t0 = tile * 32;
  const int tid = get_tid(), lane = tid & 63, wid = tid >> 6;
  bfu* zt = (bfu*)lds;
  float* outt = (float*)(lds + 62 * 256 * 2);
  __syncthreads();
  for (int id = tid; id < 62 * 32; id += 256) {
    int r = id >> 5, cc = id & 31;
    int tok = t0 - 30 + r;
    uint4 o = make_uint4(0, 0, 0, 0);
    if (tok >= 0) {
      const bfu* row = proj + ((long)b * SEQ + tok) * LDP;
      uint4 a = *(const uint4*)(row + C_CA + cc * 8);
      uint4 g = *(const uint4*)(row + C_CB + cc * 8);
      o.x = pack2(lo2f(a.x) * sigmoidf_(lo2f(g.x)), hi2f(a.x) * sigmoidf_(hi2f(g.x)));
      o.y = pack2(lo2f(a.y) * sigmoidf_(lo2f(g.y)), hi2f(a.y) * sigmoidf_(hi2f(g.y)));
      o.z = pack2(lo2f(a.z) * sigmoidf_(lo2f(g.z)), hi2f(a.z) * sigmoidf_(hi2f(g.z)));
      o.w = pack2(lo2f(a.w) * sigmoidf_(lo2f(g.w)), hi2f(a.w) * sigmoidf_(hi2f(g.w)));
    }
    *(uint4*)(zt + r * 256 + cc * 8) = o;
  }
  __syncthreads();
  {
    const int c = tid;
    float w[31];
    const float* cw = p.in[12] + (long)l * 31 * 256;
#pragma unroll
    for (int j = 0; j < 31; ++j) w[j] = cw[j * 256 + c];
    const float bias = p.in[13][l * 256 + c];
    for (int tg = 0; tg < 8; ++tg) {
      float o0 = bias, o1 = bias, o2 = bias, o3 = bias;
#pragma unroll
      for (int j = 0; j < 34; ++j) {
        float z = bf2f(zt[(tg * 4 + j) * 256 + c]);
        if (j < 31) o0 += w[j < 31 ? j : 0] * z;
        if (j >= 1 && j < 32) o1 += w[(j >= 1 && j < 32) ? j - 1 : 0] * z;
        if (j >= 2 && j < 33) o2 += w[(j >= 2 && j < 33) ? j - 2 : 0] * z;
        if (j >= 3) o3 += w[j >= 3 ? j - 3 : 0] * z;
      }
      outt[(tg * 4 + 0) * 256 + c] = o0;
      outt[(tg * 4 + 1) * 256 + c] = o1;
      outt[(tg * 4 + 2) * 256 + c] = o2;
      outt[(tg * 4 + 3) * 256 + c] = o3;
    }
  }
  __syncthreads();
  {
    float4 gg = ((const float4*)(p.in[14] + l * 256))[lane];
    float4 bb = ((const float4*)(p.in[15] + l * 256))[lane];
    for (int i = 0; i < 8; ++i) {
      int tt = wid * 8 + i;
      float4 v = *(const float4*)(outt + tt * 256 + lane * 4);
      float mean = wave_sum(v.x + v.y + v.z + v.w) * (1.f / 256.f);
      float d0 = v.x - mean, d1 = v.y - mean, d2 = v.z - mean, d3 = v.w - mean;
      float var = wave_sum(d0 * d0 + d1 * d1 + d2 * d2 + d3 * d3) * (1.f / 256.f);
      float rstd = rsqrtf(var + 1e-5f);
      float r0 = d0 * rstd * gg.x + bb.x, r1 = d1 * rstd * gg.y + bb.y, r2 = d2 * rstd * gg.z + bb.z, r3 = d3 * rstd * gg.w + bb.w;
      r0 *= sigmoidf_(r0); r1 *= sigmoidf_(r1); r2 *= sigmoidf_(r2); r3 *= sigmoidf_(r3);
      uint2 o; o.x = pack2(r0, r1); o.y = pack2(r2, r3);
      *(uint2*)(y + ((long)b * SEQ + t0 + tt) * 1024 + 512 + lane * 4) = o;
    }
  }
}

DEVI void prepass_item(const Params& p, int l, int idx, char* lds) {
  bfu* proj = (bfu*)(p.ws + OFF_PROJ);
  const int b = idx >> 5, tile = idx & 31;
  const int tid = get_tid();
  const long tok0 = (long)b * SEQ + tile * 64;
  for (int pass = 0; pass < 8; ++pass) {
    int pair = pass * 64 + (tid >> 2);
    int tokl = pair >> 3, hh = pair & 7, sub = tid & 3;
    int col;
    const float* gain;
    float mul = 1.f;
    if (hh < 4) { col = C_Q + hh * 64; gain = p.in[7] + l * 64; mul = 0.125f * 1.4426950408889634f; }
    else if (hh < 6) { col = C_KS + (hh - 4) * 64; gain = p.in[8] + (l * 3 + 1) * 64; }
    else { col = C_KW + (hh - 6) * 64; gain = p.in[8] + (l * 3 + 2) * 64; }
    bfu* ptr = proj + (tok0 + tokl) * LDP + col + sub * 16;
    uint4 u0 = *(const uint4*)ptr, u1 = *(const uint4*)(ptr + 8);
    float v[16];
    v[0] = lo2f(u0.x); v[1] = hi2f(u0.x); v[2] = lo2f(u0.y); v[3] = hi2f(u0.y);
    v[4] = lo2f(u0.z); v[5] = hi2f(u0.z); v[6] = lo2f(u0.w); v[7] = hi2f(u0.w);
    v[8] = lo2f(u1.x); v[9] = hi2f(u1.x); v[10] = lo2f(u1.y); v[11] = hi2f(u1.y);
    v[12] = lo2f(u1.z); v[13] = hi2f(u1.z); v[14] = lo2f(u1.w); v[15] = hi2f(u1.w);
    float ss = 0.f;
#pragma unroll
    for (int e = 0; e < 16; ++e) ss += v[e] * v[e];
    ss += __shfl_xor(ss, 1);
    ss += __shfl_xor(ss, 2);
    float rstd = rsqrtf(ss * (1.f / 64.f) + 1e-6f) * mul;
    const float* gp = gain + sub * 16;
#pragma unroll
    for (int e = 0; e < 16; ++e) v[e] = v[e] * rstd * gp[e];
    u0.x = pack2(v[0], v[1]); u0.y = pack2(v[2], v[3]); u0.z = pack2(v[4], v[5]); u0.w = pack2(v[6], v[7]);
    u1.x = pack2(v[8], v[9]); u1.y = pack2(v[10], v[11]); u1.z = pack2(v[12], v[13]); u1.w = pack2(v[14], v[15]);
    *(uint4*)ptr = u0; *(uint4*)(ptr + 8) = u1;
  }
  bfu* vt = (bfu*)lds;
  __syncthreads();
  for (int i = 0; i < 8; ++i) {
    int id = tid + 256 * i;
    int tokl = id >> 5, cc = id & 31;
    int col = (cc < 16) ? (C_VS + cc * 8) : (C_VW + (cc - 16) * 8);
    uint4 u = *(const uint4*)(proj + (tok0 + tokl) * LDP + col);
    *(uint4*)(vt + tokl * 264 + cc * 8) = u;
  }
  __syncthreads();
  for (int i = 0; i < 8; ++i) {
    int id = tid + 256 * i;
    int row = id & 255, ch = id >> 8;
    unsigned short e[8];
#pragma unroll
    for (int k = 0; k < 8; ++k) e[k] = vt[(ch * 8 + k) * 264 + row];
    uint4 o;
    o.x = (unsigned)e[0] | ((unsigned)e[1] << 16); o.y = (unsigned)e[2] | ((unsigned)e[3] << 16);
    o.z = (unsigned)e[4] | ((unsigned)e[5] << 16); o.w = (unsigned)e[6] | ((unsigned)e[7] << 16);
    int which = row >> 7, hd = row & 127;
    bfu* dst = (bfu*)(p.ws + (which ? OFF_VWT : OFF_VST)) + ((long)b * 128 + hd) * SEQ + tile * 64 + ch * 8;
    *(uint4*)dst = o;
  }
}

DEVI void sconv_item(const Params& p, int l, int idx) {
  const bfu* proj = (const bfu*)(p.ws + OFF_PROJ);
  bfu* y = (bfu*)(p.ws + OFF_Y);
  const int b = idx >> 5, tile = idx & 31;
  const float* sw = p.in[16] + (long)l * 3 * 256;
  for (int i = 0; i < 8; ++i) {
    int id = get_tid() + 256 * i;
    int tokl = id >> 5, cc = id & 31;
    int t = tile * 64 + tokl;
    float acc[8];
#pragma unroll
    for (int e = 0; e < 8; ++e) acc[e] = 0.f;
#pragma unroll
    for (int j = 0; j < 3; ++j) {
      int ts = t - 2 + j;
      if (ts >= 0) {
        const bfu* row = proj + ((long)b * SEQ + ts) * LDP;
        uint4 a = *(const uint4*)(row + C_SC + cc * 8);
        uint4 h = *(const uint4*)(row + C_SH + cc * 8);
        const float* w = sw + j * 256 + cc * 8;
        acc[0] += w[0] * lo2f(a.x) * lo2f(h.x); acc[1] += w[1] * hi2f(a.x) * hi2f(h.x);
        acc[2] += w[2] * lo2f(a.y) * lo2f(h.y); acc[3] += w[3] * hi2f(a.y) * hi2f(h.y);
        acc[4] += w[4] * lo2f(a.z) * lo2f(h.z); acc[5] += w[5] * hi2f(a.z) * hi2f(h.z);
        acc[6] += w[6] * lo2f(a.w) * lo2f(h.w); acc[7] += w[7] * hi2f(a.w) * hi2f(h.w);
      }
    }
    uint4 bb = *(const uint4*)(proj + ((long)b * SEQ + t) * LDP + C_SB + cc * 8);
    uint4 o;
    o.x = pack2(acc[0] * lo2f(bb.x), acc[1] * hi2f(bb.x));
    o.y = pack2(acc[2] * lo2f(bb.y), acc[3] * hi2f(bb.y));
    o.z = pack2(acc[4] * lo2f(bb.z), acc[5] * hi2f(bb.z));
    o.w = pack2(acc[6] * lo2f(bb.w), acc[7] * hi2f(bb.w));
    *(uint4*)(y + ((long)b * SEQ + t) * 1024 + 768 + cc * 8) = o;
  }
}

constexpr int P3_CMP = 32, P3_GMLP = 512, P3_CONF = 512, P3_PRE = 256, P3_SCONV = 256;
constexpr int P3_ITEMS = P3_CMP + P3_GMLP + P3_CONF + P3_PRE + P3_SCONV;

DEVI void phase3a(const Params& p, int l, char* lds) {
  for (int item = blockIdx.x; item < P3_ITEMS; item += gridDim.x) {
    int i = item;
    if (i < P3_CMP) { compress_item(p, l, i, lds); continue; }
    i -= P3_CMP;
    if (i < P3_GMLP) { gmlp_item(p, l, i, lds); continue; }
    i -= P3_GMLP;
    if (i < P3_CONF) { conf_item(p, l, i, lds); continue; }
    i -= P3_CONF;
    if (i < P3_PRE) { prepass_item(p, l, i, lds); continue; }
    i -= P3_PRE;
    sconv_item(p, l, i);
  }
}

constexpr float NEGF = -1e30f;

DEVI void compute_S(f32x4 (&s)[2][4], const bf16x8 (&qf)[2][2], const bfu* Ks, int fr, int fq) {
#pragma unroll
  for (int g = 0; g < 2; ++g)
#pragma unroll
    for (int k = 0; k < 4; ++k) s[g][k] = f32x4{0.f, 0.f, 0.f, 0.f};
#pragma unroll
  for (int ks = 0; ks < 2; ++ks)
#pragma unroll
    for (int ksub = 0; ksub < 4; ++ksub) {
      bf16x8 kf = *(const bf16x8*)(Ks + (ksub * 16 + fr) * LS + ks * 32 + fq * 8);
#pragma unroll
      for (int g = 0; g < 2; ++g) s[g][ksub] = __builtin_amdgcn_mfma_f32_16x16x32_bf16(kf, qf[g][ks], s[g][ksub], 0, 0, 0);
    }
}

DEVI void pv_accum(f32x4 (&o)[2][4], const f32x4 (&pr)[2][4], const bfu* Vt, int fr, int fq) {
#pragma unroll
  for (int kp = 0; kp < 2; ++kp) {
    bf16x8 pf[2];
#pragma unroll
    for (int g = 0; g < 2; ++g) {
      uint4 u;
      u.x = pack2(pr[g][2 * kp][0], pr[g][2 * kp][1]);
      u.y = pack2(pr[g][2 * kp][2], pr[g][2 * kp][3]);
      u.z = pack2(pr[g][2 * kp + 1][0], pr[g][2 * kp + 1][1]);
      u.w = pack2(pr[g][2 * kp + 1][2], pr[g][2 * kp + 1][3]);
      pf[g] = *(bf16x8*)&u;
    }
#pragma unroll
    for (int dsub = 0; dsub < 4; ++dsub) {
      uint2 lo = *(const uint2*)(Vt + (dsub * 16 + fr) * LS + (2 * kp) * 16 + fq * 4);
      uint2 hi = *(const uint2*)(Vt + (dsub * 16 + fr) * LS + (2 * kp + 1) * 16 + fq * 4);
      uint4 u; u.x = lo.x; u.y = lo.y; u.z = hi.x; u.w = hi.y;
      bf16x8 vf = *(bf16x8*)&u;
#pragma unroll
      for (int g = 0; g < 2; ++g) o[g][dsub] = __builtin_amdgcn_mfma_f32_16x16x32_bf16(vf, pf[g], o[g][dsub], 0, 0, 0);
    }
  }
}

struct AttnState {
  f32x4 o[2][4];
  float m[2], l[2];
};

template <typename MF>
DEVI void attn_step(AttnState& st, const bf16x8 (&qf)[2][2], const bfu* Ks, const bfu* Vt, MF valid, int fr, int fq) {
  f32x4 s[2][4];
  compute_S(s, qf, Ks, fr, fq);
#pragma unroll
  for (int g = 0; g < 2; ++g) {
    float mx = NEGF;
#pragma unroll
    for (int ksub = 0; ksub < 4; ++ksub)
#pragma unroll
      for (int j = 0; j < 4; ++j) {
        bool v = valid(ksub * 16 + fq * 4 + j);
        float sv = v ? s[g][ksub][j] : NEGF;
        s[g][ksub][j] = sv;
        mx = fmaxf(mx, sv);
      }
    mx = fmaxf(mx, __shfl_xor(mx, 16));
    mx = fmaxf(mx, __shfl_xor(mx, 32));
    float mn = fmaxf(st.m[g], mx);
    float sc = exp2f(st.m[g] - mn);
    float ps = 0.f;
#pragma unroll
    for (int ksub = 0; ksub < 4; ++ksub)
#pragma unroll
      for (int j = 0; j < 4; ++j) {
        float sv = s[g][ksub][j];
        float pv = (sv > -5e29f) ? exp2f(sv - mn) : 0.f;
        s[g][ksub][j] = pv;
        ps += pv;
      }
    ps += __shfl_xor(ps, 16);
    ps += __shfl_xor(ps, 32);
    st.l[g] = st.l[g] * sc + ps;
    st.m[g] = mn;
#pragma unroll
    for (int dsub = 0; dsub < 4; ++dsub) st.o[g][dsub] *= sc;
  }
  pv_accum(st.o, s, Vt, fr, fq);
}

DEVI void attn_init(AttnState& st) {
#pragma unroll
  for (int g = 0; g < 2; ++g) {
    st.m[g] = NEGF; st.l[g] = 0.f;
#pragma unroll
    for (int d = 0; d < 4; ++d) st.o[g][d] = f32x4{0.f, 0.f, 0.f, 0.f};
  }
}

DEVI void nsa_item(const Params& p, int l, int item, char* lds_raw) {
  bfu* Kb = (bfu*)lds_raw;
  bfu* Vb = Kb + 128 * LS;
  float* Gs = (float*)(Vb + 128 * LS);
  float* Ls_ = Gs + 64 * 33;
  float* Pb = Ls_ + 64 * 33;
  unsigned* selm = (unsigned*)(Pb + 64 * 33);
  const int qt = 31 - (item >> 4), bh = item & 15, b = bh >> 1, h = bh & 1;
  const int tid = get_tid(), lane = tid & 63, wid = tid >> 6, fr = lane & 15, fq = lane >> 4;
  const bfu* proj = (const bfu*)(p.ws + OFF_PROJ);
  const long tokbase = (long)b * SEQ;
  const int t0 = qt * 64;
  const int tokl = wid * 16 + fr;
  const int mytok = t0 + tokl;
  const bfu* myrow = proj + (tokbase + mytok) * LDP;
  bf16x8 qf[2][2];
#pragma unroll
  for (int g = 0; g < 2; ++g)
#pragma unroll
    for (int ks = 0; ks < 2; ++ks) qf[g][ks] = *(const bf16x8*)(myrow + C_Q + (h * 2 + g) * 64 + ks * 32 + fq * 8);
  float gate[2][3];
#pragma unroll
  for (int g = 0; g < 2; ++g)
#pragma unroll
    for (int br = 0; br < 3; ++br) gate[g][br] = sigmoidf_(bf2f(myrow[C_NG + (h * 2 + g) * 3 + br]));
  f32x4 fin[2][4];
#pragma unroll
  for (int g = 0; g < 2; ++g)
#pragma unroll
    for (int d = 0; d < 4; ++d) fin[g][d] = f32x4{0.f, 0.f, 0.f, 0.f};

  const int ntile = (t0 + 32 >= 1024) ? 2 : 1;
  __syncthreads();
  {
    const bfu* kc = (const bfu*)(p.ws + OFF_KCMP) + (long)(b * 2 + h) * 128 * 64;
    const bfu* vc = (const bfu*)(p.ws + OFF_VCT) + (long)(b * 2 + h) * 64 * 128;
    for (int i = 0; i < 2 * ntile; ++i) {
      int id = tid + 256 * i;
      int row = id >> 3, ch = id & 7;
      *(uint4*)(Kb + row * LS + ch * 8) = *(const uint4*)(kc + row * 64 + ch * 8);
    }
    for (int i = 0; i < 2 * ntile; ++i) {
      int id = tid + 256 * i;
      int tt = id >> 9, d = (id >> 3) & 63, ch = id & 7;
      *(uint4*)(Vb + tt * 64 * LS + d * LS + ch * 8) = *(const uint4*)(vc + d * 128 + tt * 64 + ch * 8);
    }
  }
  __syncthreads();
  {
    f32x4 s[2][2][4];
    compute_S(s[0], qf, Kb, fr, fq);
    if (ntile == 2) compute_S(s[1], qf, Kb + 64 * LS, fr, fq);
    else {
#pragma unroll
      for (int g = 0; g < 2; ++g)
#pragma unroll
        for (int k = 0; k < 4; ++k) s[1][g][k] = f32x4{0.f, 0.f, 0.f, 0.f};
    }
    float inv[2];
#pragma unroll
    for (int g = 0; g < 2; ++g) {
      float mx = NEGF;
#pragma unroll
      for (int tt = 0; tt < 2; ++tt)
#pragma unroll
        for (int ksub = 0; ksub < 4; ++ksub)
#pragma unroll
          for (int j = 0; j < 4; ++j) {
            int n = tt * 64 + ksub * 16 + fq * 4 + j;
            bool v = (n * 16 + 31 <= mytok);
            float sv = v ? s[tt][g][ksub][j] : NEGF;
            s[tt][g][ksub][j] = sv;
            mx = fmaxf(mx, sv);
          }
      mx = fmaxf(mx, __shfl_xor(mx, 16));
      mx = fmaxf(mx, __shfl_xor(mx, 32));
      float ps = 0.f;
#pragma unroll
      for (int tt = 0; tt < 2; ++tt)
#pragma unroll
        for (int ksub = 0; ksub < 4; ++ksub)
#pragma unroll
          for (int j = 0; j < 4; ++j) {
            float sv = s[tt][g][ksub][j];
            float pv = (sv > -5e29f) ? exp2f(sv - mx) : 0.f;
            s[tt][g][ksub][j] = pv;
            ps += pv;
          }
      ps += __shfl_xor(ps, 16);
      ps += __shfl_xor(ps, 32);
      inv[g] = ps > 0.f ? 1.f / ps : 0.f;
    }
#pragma unroll
    for (int tt = 0; tt < 2; ++tt)
#pragma unroll
      for (int ksub = 0; ksub < 4; ++ksub) {
#pragma unroll
        for (int g = 0; g < 2; ++g) s[tt][g][ksub] *= inv[g];
        float G = 0.f;
#pragma unroll
        for (int g = 0; g < 2; ++g) G += s[tt][g][ksub][0] + s[tt][g][ksub][1] + s[tt][g][ksub][2] + s[tt][g][ksub][3];
        float Lv = s[tt][0][ksub][3] + s[tt][1][ksub][3];
        int J = tt * 16 + ksub * 4 + fq;
        Gs[tokl * 33 + J] = G;
        Ls_[tokl * 33 + J] = Lv;
      }
    f32x4 o[2][4];
#pragma unroll
    for (int g = 0; g < 2; ++g)
#pragma unroll
      for (int d = 0; d < 4; ++d) o[g][d] = f32x4{0.f, 0.f, 0.f, 0.f};
    pv_accum(o, s[0], Vb, fr, fq);
    if (ntile == 2) pv_accum(o, s[1], Vb + 64 * LS, fr, fq);
#pragma unroll
    for (int g = 0; g < 2; ++g)
#pragma unroll
      for (int d = 0; d < 4; ++d) fin[g][d] += o[g][d] * gate[g][0];
  }
  __syncthreads();
  if (tid < 64) {
    const int cur = qt;
    unsigned forced = 1u | (1u << cur) | (cur > 0 ? (1u << (cur - 1)) : 0u);
    unsigned sel = forced;
    int cnt = __popc(forced);
    for (int J = 0; J < 32; ++J) {
      float v = Gs[tid * 33 + J];
      if (J > 0) v += Ls_[tid * 33 + J - 1];
      Pb[tid * 33 + J] = v;
    }
    while (cnt < 8) {
      int best = -1;
      float bv = -1.f;
      for (int J = 0; J <= cur; ++J) {
        float v = Pb[tid * 33 + J];
        if (!((sel >> J) & 1u) && v > bv) { bv = v; best = J; }
      }
      if (best < 0) break;
      sel |= 1u << best;
      ++cnt;
    }
    selm[tid] = sel;
    unsigned om = sel;
#pragma unroll
    for (int o = 32; o >= 1; o >>= 1) om |= (unsigned)__shfl_xor((int)om, o);
    if (tid == 0) selm[64] = om;
  }
  __syncthreads();
  const unsigned mysel = selm[tokl];
  const unsigned ormask = selm[64];

  uint4 rk0, rk1, rv0, rv1;
#define KV_LOAD(KB, VB, JJ)                                                           \
  do {                                                                               \
    rk0 = *(const uint4*)((KB) + (long)((JJ) * 64 + (tid >> 3)) * LDP + (tid & 7) * 8);        \
    rk1 = *(const uint4*)((KB) + (long)((JJ) * 64 + 32 + (tid >> 3)) * LDP + (tid & 7) * 8);   \
    rv0 = *(const uint4*)((VB) + (long)(tid >> 3) * SEQ + (JJ) * 64 + (tid & 7) * 8);          \
    rv1 = *(const uint4*)((VB) + (long)(32 + (tid >> 3)) * SEQ + (JJ) * 64 + (tid & 7) * 8);   \
  } while (0)
#define KV_STORE()                                                    \
  do {                                                                \
    *(uint4*)(Kb + (tid >> 3) * LS + (tid & 7) * 8) = rk0;            \
    *(uint4*)(Kb + (32 + (tid >> 3)) * LS + (tid & 7) * 8) = rk1;     \
    *(uint4*)(Vb + (tid >> 3) * LS + (tid & 7) * 8) = rv0;            \
    *(uint4*)(Vb + (32 + (tid >> 3)) * LS + (tid & 7) * 8) = rv1;     \
  } while (0)
  {
    AttnState st;
    attn_init(st);
    const bfu* kbase = proj + tokbase * LDP + C_KS + h * 64;
    const bfu* vbase = (const bfu*)(p.ws + OFF_VST) + ((long)b * 128 + h * 64) * SEQ;
    unsigned rem = ormask & ((2u << qt) - 1u);
    int j = __ffs(rem) - 1;
    KV_LOAD(kbase, vbase, j);
    while (rem) {
      j = __ffs(rem) - 1;
      rem &= rem - 1;
      __syncthreads();
      KV_STORE();
      __syncthreads();
      if (rem) {
        int jn = __ffs(rem) - 1;
        KV_LOAD(kbase, vbase, jn);
      }
      const bool insel = (mysel >> j) & 1u;
      const int kb0 = j * 64;
      attn_step(st, qf, Kb, Vb, [&](int kl) { return insel && (kb0 + kl <= mytok); }, fr, fq);
    }
#pragma unroll
    for (int g = 0; g < 2; ++g) {
      float sc = (st.l[g] > 0.f ? 1.f / st.l[g] : 0.f) * gate[g][1];
#pragma unroll
      for (int d = 0; d < 4; ++d) fin[g][d] += st.o[g][d] * sc;
    }
  }
  {
    AttnState st;
    attn_init(st);
    const bfu* kbase = proj + tokbase * LDP + C_KW + h * 64;
    const bfu* vbase = (const bfu*)(p.ws + OFF_VWT) + ((long)b * 128 + h * 64) * SEQ;
    int j = qt - 8 < 0 ? 0 : qt - 8;
    KV_LOAD(kbase, vbase, j);
    for (; j <= qt; ++j) {
      __syncthreads();
      KV_STORE();
      __syncthreads();
      if (j < qt) {
        int jn = j + 1;
        KV_LOAD(kbase, vbase, jn);
      }
      const int kb0 = j * 64;
      attn_step(st, qf, Kb, Vb, [&](int kl) { int kp = kb0 + kl; return (kp <= mytok) && (kp > mytok - 512); }, fr, fq);
    }
#pragma unroll
    for (int g = 0; g < 2; ++g) {
      float sc = (st.l[g] > 0.f ? 1.f / st.l[g] : 0.f) * gate[g][2];
#pragma unroll
      for (int d = 0; d < 4; ++d) fin[g][d] += st.o[g][d] * sc;
    }
  }
  bfu* y = (bfu*)(p.ws + OFF_Y) + (tokbase + mytok) * 1024 + 256 + h * 128;
#pragma unroll
  for (int g = 0; g < 2; ++g)
#pragma unroll
    for (int d = 0; d < 4; ++d) store_bf4(y + g * 64 + d * 16 + fq * 4, fin[g][d]);
}

DEVI void phase3b(const Params& p, int l, char* lds) {
  for (int item = blockIdx.x; item < 512; item += gridDim.x) nsa_item(p, l, item, lds);
}

DEVI void phase4(const Params& p, int l, char* lds) {
  const bfu* xn = (const bfu*)(p.ws + OFF_XN);
  const bfu* y = (const bfu*)(p.ws + OFF_Y);
  const bfu* wg = (const bfu*)(p.ws + OFF_WGATE);
  const bfu* wb = (const bfu*)(p.ws + OFF_WBR);
  bfu* mixed = (bfu*)(p.ws + OFF_MIX);
  const float* bg = p.in[19] + (long)l * 4096;
  const int lane = get_tid() & 63, wid = get_tid() >> 6, wm = wid >> 1, wn = wid & 1, fr = lane & 15, fq = lane >> 4;
  for (int t = blockIdx.x; t < 128 * 16; t += gridDim.x) {
    int mt = t >> 4, nt = t & 15;
    int m0 = mt * 128, n0 = nt * 64;
    f32x4 mix[2][4];
    zero_acc<2>(mix);
#pragma unroll 1
    for (int bb = 0; bb < 4; ++bb) {
      f32x4 accP[2][4], accG[2][4];
      zero_acc<2>(accP);
      zero_acc<2>(accG);
      gemm_core<64>(accP, [&](int r) { return y + (long)(m0 + r) * 1024 + bb * 256; }, 64,
                    wb + ((long)bb * 1024 + n0) * 256, 256, 4, (bfu*)lds);
      gemm_core<64>(accG, [&](int r) { return xn + (long)(m0 + r) * 1024; }, 64,
                    wg + ((long)bb * 1024 + n0) * 1024, 1024, 16, (bfu*)lds);
#pragma unroll
      for (int ni = 0; ni < 2; ++ni) {
        int n = n0 + wn * 32 + ni * 16 + fq * 4;
        float4 bv = *(const float4*)(bg + bb * 1024 + n);
#pragma unroll
        for (int mi = 0; mi < 4; ++mi) {
          mix[ni][mi][0] += sigmoidf_(accG[ni][mi][0] + bv.x) * accP[ni][mi][0];
          mix[ni][mi][1] += sigmoidf_(accG[ni][mi][1] + bv.y) * accP[ni][mi][1];
          mix[ni][mi][2] += sigmoidf_(accG[ni][mi][2] + bv.z) * accP[ni][mi][2];
          mix[ni][mi][3] += sigmoidf_(accG[ni][mi][3] + bv.w) * accP[ni][mi][3];
        }
      }
    }
#pragma unroll
    for (int ni = 0; ni < 2; ++ni)
#pragma unroll
      for (int mi = 0; mi < 4; ++mi) {
        int n = n0 + wn * 32 + ni * 16 + fq * 4;
        int m = m0 + wm * 64 + mi * 16 + fr;
        store_bf4(mixed + (long)m * 1024 + n, mix[ni][mi]);
      }
  }
}

DEVI void phase_resid_gemm(const Params& p, const bfu* A, int lda, int nkt, const bfu* wT, const float* resid, char* lds) {
  const int lane = get_tid() & 63, wid = get_tid() >> 6, wm = wid >> 1, wn = wid & 1, fr = lane & 15, fq = lane >> 4;
  const int ldb = nkt * 64;
  for (int t = blockIdx.x; t < 128 * 8; t += gridDim.x) {
    int mt = t >> 3, nt = t & 7;
    int m0 = mt * 128, n0 = nt * 128;
    f32x4 acc[4][4];
    zero_acc<4>(acc);
    gemm_core<128>(acc, [&](int r) { return A + (long)(m0 + r) * lda; }, 64, wT + (long)n0 * ldb, ldb, nkt, (bfu*)lds);
#pragma unroll
    for (int ni = 0; ni < 4; ++ni)
#pragma unroll
      for (int mi = 0; mi < 4; ++mi) {
        int n = n0 + wn * 64 + ni * 16 + fq * 4;
        int m = m0 + wm * 64 + mi * 16 + fr;
        float4 r = *(const float4*)(resid + (long)m * 1024 + n);
        float4 o;
        o.x = r.x + acc[ni][mi][0]; o.y = r.y + acc[ni][mi][1]; o.z = r.z + acc[ni][mi][2]; o.w = r.w + acc[ni][mi][3];
        *(float4*)(p.out + (long)m * 1024 + n) = o;
      }
  }
}

DEVI void phase6(const Params& p, int l) {
  for (int item = blockIdx.x; item < 1024; item += gridDim.x)
    rms_rows(p.out, p.in[21] + l * 1024, (bfu*)(p.ws + OFF_XN), item);
}

DEVI void phase7(const Params& p, int l, char* lds) {
  const bfu* hn = (const bfu*)(p.ws + OFF_XN);
  const bfu* wT = (const bfu*)(p.ws + OFF_WM1);
  bfu* hid = (bfu*)(p.ws + OFF_HID);
  const int lane = get_tid() & 63, wid = get_tid() >> 6, wm = wid >> 1, wn = wid & 1, fr = lane & 15, fq = lane >> 4;
  for (int t = blockIdx.x; t < 128 * 32; t += gridDim.x) {
    int mt = t >> 5, nt = t & 31;
    int m0 = mt * 128, n0 = nt * 128;
    f32x4 acc[4][4];
    zero_acc<4>(acc);
    gemm_core<128>(acc, [&](int r) { return hn + (long)(m0 + r) * 1024; }, 64, wT + (long)n0 * 1024, 1024, 16, (bfu*)lds);
#pragma unroll
    for (int ni = 0; ni < 4; ++ni)
#pragma unroll
      for (int mi = 0; mi < 4; ++mi) {
        f32x4 v = acc[ni][mi];
#pragma unroll
        for (int j = 0; j < 4; ++j) { float r = fmaxf(v[j], 0.f); v[j] = r * r; }
        int n = n0 + wn * 64 + ni * 16 + fq * 4;
        int m = m0 + wm * 64 + mi * 16 + fr;
        store_bf4(hid + (long)m * 4096 + n, v);
      }
  }
}

constexpr int PH_PER_LAYER = 9;
constexpr int N_PHASES = 2 * PH_PER_LAYER;

DEVI void run_phase(const Params& p, int ph, char* lds) {
  const int l = ph / PH_PER_LAYER, q = ph % PH_PER_LAYER;
  switch (q) {
    case 0: phase1(p, l, lds); break;
    case 1: phase2(p, l, lds); break;
    case 2: phase3a(p, l, lds); break;
    case 3: phase3b(p, l, lds); break;
    case 4: phase4(p, l, lds); break;
    case 5: phase_resid_gemm(p, (const bfu*)(p.ws + OFF_MIX), 1024, 16, (const bfu*)(p.ws + OFF_WOUT),
                             (l == 0) ? p.in[0] : p.out, lds); break;
    case 6: phase6(p, l); break;
    case 7: phase7(p, l, lds); break;
    case 8: phase_resid_gemm(p, (const bfu*)(p.ws + OFF_HID), 4096, 64, (const bfu*)(p.ws + OFF_WM2), p.out, lds); break;
  }
}

__global__ void __launch_bounds__(256, 2) fwd_mega(Params p, int ph_lo, int ph_hi, int coop) {
  extern __shared__ __attribute__((aligned(16))) char lds[];
  for (int ph = ph_lo; ph < ph_hi; ++ph) {
    run_phase(p, ph, lds);
    if (coop && ph + 1 < ph_hi) cg::this_grid().sync();
  }
}

extern "C" void kernel_launch(void* const* d_in, const int* in_sizes, int n_in, void* d_out, int out_size, void* d_ws,
                              size_t ws_size, hipStream_t stream) {
  static int grid_blocks = 0;
  if (!grid_blocks) {
    int dev = 0, cus = 0, per_cu = 0;
    hipGetDevice(&dev);
    hipDeviceGetAttribute(&cus, hipDeviceAttributeMultiprocessorCount, dev);
    hipFuncSetAttribute((const void*)fwd_mega, hipFuncAttributeMaxDynamicSharedMemorySize, LDS_BYTES);
    hipOccupancyMaxActiveBlocksPerMultiprocessor(&per_cu, (const void*)fwd_mega, 256, LDS_BYTES);
    if (per_cu < 1) per_cu = 1;
    if (per_cu > 2) per_cu = 2;
    grid_blocks = cus * per_cu;
    if (ws_size < WS_TOTAL) fprintf(stderr, "workspace too small: %zu < %zu\n", ws_size, (size_t)WS_TOTAL);
  }
  Params p{};
  for (int i = 0; i < 24; ++i) p.in[i] = (const float*)d_in[i];
  p.out = (float*)d_out;
  p.ws = (char*)d_ws;
#if MULTI_LAUNCH
  for (int ph = 0; ph < N_PHASES; ++ph) {
    hipLaunchKernelGGL(fwd_mega, dim3(grid_blocks), dim3(256), LDS_BYTES, stream, p, ph, ph + 1, 0);
  }
#else
  int lo = 0, hi = N_PHASES, coop = 1;
  void* args[] = {&p, &lo, &hi, &coop};
  hipError_t e = hipLaunchCooperativeKernel((const void*)fwd_mega, dim3(grid_blocks), dim3(256), args, LDS_BYTES, stream);
  if (e != hipSuccess) fprintf(stderr, "cooperative launch failed: %s (grid %d)\n", hipGetErrorString(e), grid_blocks);
#endif
}
```

```cpp
#include <hip/hip_runtime.h>
#include <hip/hip_cooperative_groups.h>
#include <cstdio>
namespace cg = cooperative_groups;

#ifndef MULTI_LAUNCH
#define MULTI_LAUNCH 0
#endif

#define DEVI __device__ __forceinline__
typedef unsigned short bfu;
using bf16x8 = __attribute__((ext_vector_type(8))) short;
using bf16x4 = __attribute__((ext_vector_type(4))) short;
using f32x4  = __attribute__((ext_vector_type(4))) float;

constexpr int NTOK = 16384, SEQ = 2048;
constexpr int LDP = 3072;
constexpr int C_GU = 0, C_GV = 256, C_Q = 512, C_KC = 768, C_VC = 896, C_KS = 1024, C_VS = 1152, C_KW = 1280,
              C_VW = 1408, C_CA = 1536, C_CB = 1792, C_SB = 2048, C_SC = 2304, C_SH = 2560, C_NG = 2816;
constexpr int LDS_HALF = 73728;
constexpr int LDS_BYTES = 2 * LDS_HALF;
constexpr int LDX = 1088;
constexpr int LDH = 4160;
constexpr int LDBR = 320;
constexpr int LS = 72;

constexpr size_t OFF_WIN = 0;
constexpr size_t OFF_WGATE = OFF_WIN + (size_t)LDP * LDX * 2;
constexpr size_t OFF_WBR = OFF_WGATE + (size_t)4096 * LDX * 2;
constexpr size_t OFF_WOUT = OFF_WBR + (size_t)4096 * LDBR * 2;
constexpr size_t OFF_WM1 = OFF_WOUT + (size_t)1024 * LDX * 2;
constexpr size_t OFF_WM2 = OFF_WM1 + (size_t)4096 * LDX * 2;
constexpr size_t OFF_CW1 = OFF_WM2 + (size_t)1024 * LDH * 2;
constexpr size_t OFF_CW2 = OFF_CW1 + 1048576;
constexpr size_t OFF_XN = OFF_CW2 + 32768;
constexpr size_t OFF_PROJ = OFF_XN + (size_t)16384 * LDX * 2;
constexpr size_t OFF_Y = OFF_PROJ + (size_t)16384 * LDP * 2;
constexpr size_t OFF_MIX = OFF_Y + (size_t)16384 * LDX * 2;
constexpr size_t OFF_HID = OFF_PROJ;
constexpr size_t OFF_KCMP = OFF_MIX + (size_t)16384 * LDX * 2;
constexpr size_t OFF_VCT = OFF_KCMP + 262144;
constexpr size_t OFF_VST = OFF_VCT + 262144;
constexpr size_t OFF_VWT = OFF_VST + 4194304;
constexpr size_t OFF_CHID = OFF_VWT + 4194304;
constexpr size_t OFF_PEB = OFF_CHID + 1048576;
constexpr size_t OFF_SSQA = OFF_PEB + 2 * 32 * LDP * 2;
constexpr size_t OFF_SSQB = OFF_SSQA + 16384 * 16;
constexpr size_t OFF_BAR = OFF_SSQB + 16384 * 16;
constexpr size_t WS_TOTAL = OFF_BAR + 16384;
static_assert((size_t)16384 * LDH * 2 <= OFF_KCMP - OFF_PROJ, "hid overlay does not fit");
static_assert(WS_TOTAL <= (size_t)256 * 1024 * 1024, "workspace too large");

struct Params {
  const float* in[24];
  float* out;
  char* ws;
};

DEVI int get_tid() { int t = threadIdx.x & 255; asm volatile("" : "+v"(t)); return t; }
DEVI int get_tid512() { int t = threadIdx.x; asm volatile("" : "+v"(t)); return t; }
DEVI int vhalf() { int t = threadIdx.x >> 8; t = __builtin_amdgcn_readfirstlane(t); return t; }
DEVI int vblk() { return (int)blockIdx.x * 2 + vhalf(); }
DEVI int vgrid() { return (int)gridDim.x * 2; }
DEVI bfu f2bf(float f) {
  unsigned u = __float_as_uint(f);
  u += 0x7fffu + ((u >> 16) & 1u);
  return (bfu)(u >> 16);
}
DEVI float bf2f(bfu h) { return __uint_as_float(((unsigned)h) << 16); }
typedef __bf16 hwbf2 __attribute__((ext_vector_type(2)));
typedef float hwf2 __attribute__((ext_vector_type(2)));
DEVI unsigned pack2(float a, float b) {
  hwf2 v; v.x = a; v.y = b;
  hwbf2 r = __builtin_convertvector(v, hwbf2);
  return *(unsigned*)&r;
}
DEVI float lo2f(unsigned u) { return __uint_as_float(u << 16); }
DEVI float hi2f(unsigned u) { return __uint_as_float(u & 0xffff0000u); }
DEVI float sigmoidf_(float x) { return __builtin_amdgcn_rcpf(1.f + __expf(-x)); }
DEVI float gelu_f(float x) {
  float u = 0.7978845608028654f * (x + 0.044715f * x * x * x);
  return x * __builtin_amdgcn_rcpf(1.f + __expf(-2.f * u));
}
DEVI void store_bf4(bfu* p, f32x4 v) {
  uint2 u; u.x = pack2(v[0], v[1]); u.y = pack2(v[2], v[3]);
  *(uint2*)p = u;
}
DEVI float wave_sum(float v) {
#pragma unroll
  for (int o = 32; o >= 1; o >>= 1) v += __shfl_xor(v, o);
  return v;
}

template <int BN, typename AF>
DEVI void gemm_core(f32x4 (&acc)[BN / 32][4], AF arow, long a_kstride, const bfu* __restrict__ Bt, int ldb, int nkt,
                    bfu* lds) {
  constexpr int NI = BN / 32;
  constexpr int BCH = BN * 8 / 256;
  bfu* As = lds;
  bfu* Bs = lds + 2 * 128 * LS;
  const int tid = get_tid(), lane = tid & 63, wid = tid >> 6, wm = wid >> 1, wn = wid & 1;
  const int fr = lane & 15, fq = lane >> 4;
  const bfu* ap[4];
  const bfu* bp[BCH];
#pragma unroll
  for (int i = 0; i < 4; ++i) { int id = tid + 256 * i; ap[i] = arow(id >> 3) + (id & 7) * 8; }
#pragma unroll
  for (int i = 0; i < BCH; ++i) { int id = tid + 256 * i; bp[i] = Bt + (long)(id >> 3) * ldb + (id & 7) * 8; }
  uint4 ra0_0, ra1_0, ra2_0, ra3_0, rb0_0, rb1_0, rb2_0 = make_uint4(0, 0, 0, 0), rb3_0 = make_uint4(0, 0, 0, 0);
  uint4 ra0_1, ra1_1, ra2_1, ra3_1, rb0_1, rb1_1, rb2_1 = make_uint4(0, 0, 0, 0), rb3_1 = make_uint4(0, 0, 0, 0);
#define G_LOAD(S, KT)                                                     \
  do {                                                                    \
    ra0_##S = *(const uint4*)(ap[0] + (long)(KT) * a_kstride);            \
    ra1_##S = *(const uint4*)(ap[1] + (long)(KT) * a_kstride);            \
    ra2_##S = *(const uint4*)(ap[2] + (long)(KT) * a_kstride);            \
    ra3_##S = *(const uint4*)(ap[3] + (long)(KT) * a_kstride);            \
    rb0_##S = *(const uint4*)(bp[0] + (KT) * 64);                         \
    rb1_##S = *(const uint4*)(bp[1] + (KT) * 64);                         \
    if constexpr (BCH == 4) {                                             \
      rb2_##S = *(const uint4*)(bp[2] + (KT) * 64);                       \
      rb3_##S = *(const uint4*)(bp[3] + (KT) * 64);                       \
    }                                                                     \
  } while (0)
#define L_STORE(S, AW, BW)                                                \
  do {                                                                    \
    *(uint4*)((AW) + ((tid) >> 3) * LS + (tid & 7) * 8) = ra0_##S;        \
    *(uint4*)((AW) + ((tid + 256) >> 3) * LS + (tid & 7) * 8) = ra1_##S;  \
    *(uint4*)((AW) + ((tid + 512) >> 3) * LS + (tid & 7) * 8) = ra2_##S;  \
    *(uint4*)((AW) + ((tid + 768) >> 3) * LS + (tid & 7) * 8) = ra3_##S;  \
    *(uint4*)((BW) + ((tid) >> 3) * LS + (tid & 7) * 8) = rb0_##S;        \
    *(uint4*)((BW) + ((tid + 256) >> 3) * LS + (tid & 7) * 8) = rb1_##S;  \
    if constexpr (BCH == 4) {                                             \
      *(uint4*)((BW) + ((tid + 512) >> 3) * LS + (tid & 7) * 8) = rb2_##S;\
      *(uint4*)((BW) + ((tid + 768) >> 3) * LS + (tid & 7) * 8) = rb3_##S;\
    }                                                                     \
  } while (0)
#define COMPUTE(BUF)                                                                                              \
  do {                                                                                                            \
    const bfu* Ab = As + (BUF) * 128 * LS;                                                                        \
    const bfu* Bb = Bs + (BUF) * BN * LS;                                                                         \
    _Pragma("unroll") for (int ks = 0; ks < 2; ++ks) {                                                            \
      bf16x8 tf[4], wf[NI];                                                                                       \
      _Pragma("unroll") for (int mi = 0; mi < 4; ++mi)                                                            \
        tf[mi] = *(const bf16x8*)(Ab + (wm * 64 + mi * 16 + fr) * LS + ks * 32 + fq * 8);                         \
      _Pragma("unroll") for (int ni = 0; ni < NI; ++ni)                                                           \
        wf[ni] = *(const bf16x8*)(Bb + (wn * (BN / 2) + ni * 16 + fr) * LS + ks * 32 + fq * 8);                   \
      _Pragma("unroll") for (int ni = 0; ni < NI; ++ni)                                                           \
        _Pragma("unroll") for (int mi = 0; mi < 4; ++mi)                                                          \
          acc[ni][mi] = __builtin_amdgcn_mfma_f32_16x16x32_bf16(wf[ni], tf[mi], acc[ni][mi], 0, 0, 0);            \
    }                                                                                                             \
  } while (0)
  G_LOAD(0, 0);
  if (nkt > 1) G_LOAD(1, 1);
  L_STORE(0, As, Bs);
  __syncthreads();
#pragma unroll 1
  for (int kt = 0; kt < nkt; kt += 2) {
    if (kt + 2 < nkt) G_LOAD(0, kt + 2);
    COMPUTE(0);
    if (kt + 1 < nkt) L_STORE(1, As + 128 * LS, Bs + BN * LS);
    __syncthreads();
    if (kt + 1 < nkt) {
      if (kt + 3 < nkt) G_LOAD(1, kt + 3);
      COMPUTE(1);
      if (kt + 2 < nkt) L_STORE(0, As, Bs);
      __syncthreads();
    }
  }
#undef G_LOAD
#undef L_STORE
#undef COMPUTE
}

template <bool PF2>
DEVI void gemm8(f32x4 (&acc)[4][4], const bfu* __restrict__ A, int lda, const bfu* __restrict__ Bt, int ldb, int nkt, bfu* lds) {
  constexpr int LS8 = 64;
  bfu* As = lds;
  bfu* Bs = lds + 2 * 256 * LS8;
  const int tid = get_tid512(), lane = tid & 63, wid = tid >> 6, wm = wid >> 1, wn = wid & 1;
  const int fr = lane & 15, fq = lane >> 4;
  const int wsw = (((tid & 7) ^ ((tid >> 4) & 7)) * 8);
  const int rsw = fr >> 1;
  const char* Ac = (const char*)A;
  const char* Bc = (const char*)Bt;
  const unsigned voffA = (unsigned)(((tid >> 3) * lda + (tid & 7) * 8) * 2);
  const unsigned voffB = (unsigned)(((tid >> 3) * ldb + (tid & 7) * 8) * 2);
  const size_t strA = (size_t)64 * lda * 2, strB = (size_t)64 * ldb * 2;
  uint4 ra0_0, ra1_0, ra2_0, ra3_0, rb0_0, rb1_0;
  uint4 ra0_1 = make_uint4(0, 0, 0, 0), ra1_1 = ra0_1, ra2_1 = ra0_1, ra3_1 = ra0_1, rb0_1 = ra0_1, rb1_1 = ra0_1;
#define G_LOAD(S, KT)                                          \
  do {                                                         \
    ra0_##S = *(const uint4*)(Ac + (size_t)(KT) * 128 + voffA);                 \
    ra1_##S = *(const uint4*)(Ac + strA + (size_t)(KT) * 128 + voffA);          \
    ra2_##S = *(const uint4*)(Ac + 2 * strA + (size_t)(KT) * 128 + voffA);      \
    ra3_##S = *(const uint4*)(Ac + 3 * strA + (size_t)(KT) * 128 + voffA);      \
    rb0_##S = *(const uint4*)(Bc + (size_t)(KT) * 128 + voffB);                 \
    rb1_##S = *(const uint4*)(Bc + strB + (size_t)(KT) * 128 + voffB);          \
  } while (0)
#define L_STORE(S, AW, BW)                                                  \
  do {                                                                      \
    *(uint4*)((AW) + ((tid) >> 3) * LS8 + wsw) = ra0_##S;          \
    *(uint4*)((AW) + ((tid + 512) >> 3) * LS8 + wsw) = ra1_##S;    \
    *(uint4*)((AW) + ((tid + 1024) >> 3) * LS8 + wsw) = ra2_##S;   \
    *(uint4*)((AW) + ((tid + 1536) >> 3) * LS8 + wsw) = ra3_##S;   \
    *(uint4*)((BW) + ((tid) >> 3) * LS8 + wsw) = rb0_##S;          \
    *(uint4*)((BW) + ((tid + 512) >> 3) * LS8 + wsw) = rb1_##S;    \
  } while (0)
#define COMPUTE(BUF)                                                                                              \
  do {                                                                                                            \
    const bfu* Ab = As + (BUF) * 256 * LS8;                                                                       \
    const bfu* Bb = Bs + (BUF) * 128 * LS8;                                                                       \
    _Pragma("unroll") for (int ks = 0; ks < 2; ++ks) {                                                            \
      bf16x8 tf[4];                                                                                               \
      _Pragma("unroll") for (int mi = 0; mi < 4; ++mi)                                                            \
        tf[mi] = *(const bf16x8*)(Ab + (wm * 64 + mi * 16 + fr) * LS8 + (((ks * 4 + fq) ^ rsw) * 8));                         \
      if constexpr (PF2) {                                                                                        \
        bf16x8 wf[4];                                                                                             \
        _Pragma("unroll") for (int ni = 0; ni < 4; ++ni)                                                          \
          wf[ni] = *(const bf16x8*)(Bb + (wn * 64 + ni * 16 + fr) * LS8 + (((ks * 4 + fq) ^ rsw) * 8));                       \
        _Pragma("unroll") for (int ni = 0; ni < 4; ++ni)                                                          \
          _Pragma("unroll") for (int mi = 0; mi < 4; ++mi)                                                        \
            acc[ni][mi] = __builtin_amdgcn_mfma_f32_16x16x32_bf16(wf[ni], tf[mi], acc[ni][mi], 0, 0, 0);          \
      } else {                                                                                                    \
        _Pragma("unroll") for (int ni = 0; ni < 4; ++ni) {                                                        \
          bf16x8 wf1 = *(const bf16x8*)(Bb + (wn * 64 + ni * 16 + fr) * LS8 + (((ks * 4 + fq) ^ rsw) * 8));                   \
          _Pragma("unroll") for (int mi = 0; mi < 4; ++mi)                                                        \
            acc[ni][mi] = __builtin_amdgcn_mfma_f32_16x16x32_bf16(wf1, tf[mi], acc[ni][mi], 0, 0, 0);             \
          __builtin_amdgcn_sched_barrier(0);                                                                      \
        }                                                                                                         \
      }                                                                                                           \
    }                                                                                                             \
  } while (0)
  if constexpr (PF2) {
    G_LOAD(0, 0);
    if (nkt > 1) G_LOAD(1, 1);
    L_STORE(0, As, Bs);
    __syncthreads();
#pragma unroll 1
    for (int kt = 0; kt < nkt; kt += 2) {
      if (kt + 2 < nkt) G_LOAD(0, kt + 2);
      COMPUTE(0);
      if (kt + 1 < nkt) L_STORE(1, As + 256 * LS8, Bs + 128 * LS8);
      __syncthreads();
      if (kt + 1 < nkt) {
        if (kt + 3 < nkt) G_LOAD(1, kt + 3);
        COMPUTE(1);
        if (kt + 2 < nkt) L_STORE(0, As, Bs);
        __syncthreads();
      }
    }
  } else {
    G_LOAD(0, 0);
    L_STORE(0, As, Bs);
    __syncthreads();
#pragma unroll 1
    for (int kt = 0; kt < nkt; ++kt) {
      const int buf = kt & 1;
      const bool more = kt + 1 < nkt;
      if (more) G_LOAD(0, kt + 1);
      COMPUTE(buf);
      if (more) L_STORE(0, As + (buf ^ 1) * 256 * LS8, Bs + (buf ^ 1) * 128 * LS8);
      __syncthreads();
    }
  }
#undef G_LOAD
#undef L_STORE
#undef COMPUTE
}

#define RAW_BARRIER() do { asm volatile("s_waitcnt lgkmcnt(0)" ::: "memory"); __builtin_amdgcn_s_barrier(); } while (0)
DEVI void glds16(const char* g, char* l) {
  __builtin_amdgcn_global_load_lds((const unsigned*)g, (__attribute__((address_space(3))) unsigned*)l, 16, 0, 0);
}
struct GUnit { const bfu* A; const bfu* B; int lda, ldb, nkt; };
struct GRing { int st, st2; };

template <bool WIDE>
DEVI void gemm8s(f32x4 (&acc)[4][4], const GUnit& cur, const GUnit& nxt, bool has_next, bool first, GRing& rg, bfu* lds) {
  constexpr int STGB = 384 * 128;
  const int tid = get_tid512(), lane = tid & 63, wid = tid >> 6, wm = wid >> 1, wn = wid & 1;
  const int fr = lane & 15, fq = lane >> 4;
  const int rsw = fr >> 1;
  const int lc = (tid & 7) ^ ((tid >> 4) & 7);
  const int rr = tid >> 3;
  const int lc8 = lc * 8;
  char* lbase = (char*)lds + __builtin_amdgcn_readfirstlane(wid) * 1024;
  const int nkt = cur.nkt;
#define ISSUE(AC, BC, SA, SB, VA, VB, KT, ST)                                      \
  do {                                                                             \
    char* sb = lbase + (ST) * STGB;                                                \
    const size_t ko = (size_t)(KT) * 128;                                          \
    glds16((AC) + ko + (VA), sb);                                                  \
    glds16((AC) + (SA) + ko + (VA), sb + 8192);                                    \
    glds16((AC) + 2 * (SA) + ko + (VA), sb + 16384);                               \
    glds16((AC) + 3 * (SA) + ko + (VA), sb + 24576);                               \
    glds16((BC) + ko + (VB), sb + 32768);                                          \
    glds16((BC) + (SB) + ko + (VB), sb + 40960);                                   \
  } while (0)
  const char* Acc = (const char*)cur.A;
  const char* Bcc = (const char*)cur.B;
  const size_t sAc = (size_t)64 * cur.lda * 2, sBc = (size_t)64 * cur.ldb * 2;
  const char* Acn = (const char*)nxt.A;
  const char* Bcn = (const char*)nxt.B;
  const size_t sAn = (size_t)64 * nxt.lda * 2, sBn = (size_t)64 * nxt.ldb * 2;
  if (first) {
    asm volatile("s_waitcnt vmcnt(0)" ::: "memory");
    const unsigned v0A = (unsigned)((rr * cur.lda + lc8) * 2), v0B = (unsigned)((rr * cur.ldb + lc8) * 2);
    ISSUE(Acc, Bcc, sAc, sBc, v0A, v0B, 0, rg.st);
    ISSUE(Acc, Bcc, sAc, sBc, v0A, v0B, 1, (rg.st == 2) ? 0 : rg.st + 1);
  }
  int st = rg.st, st2 = rg.st2;
  const int grp = WIDE ? 0 : __builtin_amdgcn_readfirstlane(wid >> 2);
  if (grp == 0) {
#pragma unroll 1
  for (int kt = 0; kt < nkt; ++kt) {
    if (kt == 0 && !first) asm volatile("s_waitcnt vmcnt(0)" ::: "memory");
    else asm volatile("s_waitcnt vmcnt(6)" ::: "memory");
    RAW_BARRIER();
    const bool own = (kt + 2 < nkt);
    const bool fromn = !own && has_next;
    const int tk = own ? kt + 2 : (fromn ? kt + 2 - nkt : nkt - 1);
    const char* Ai = fromn ? Acn : Acc;
    const char* Bi = fromn ? Bcn : Bcc;
    const size_t sAi = fromn ? sAn : sAc, sBi = fromn ? sBn : sBc;
    const int ldai_ = fromn ? nxt.lda : cur.lda, ldbi_ = fromn ? nxt.ldb : cur.ldb;
    const unsigned vAi = (unsigned)((rr * ldai_ + lc8) * 2), vBi = (unsigned)((rr * ldbi_ + lc8) * 2);
    const bfu* Ab = (const bfu*)((const char*)lds + st * STGB);
    const bfu* Bb = Ab + 256 * 64;
    bf16x8 tf[2][4], wf[2][4];
#pragma unroll
    for (int ks = 0; ks < 2; ++ks) {
#pragma unroll
      for (int mi = 0; mi < 4; ++mi) tf[ks][mi] = *(const bf16x8*)(Ab + (wm * 64 + mi * 16 + fr) * 64 + (((ks * 4 + fq) ^ rsw) * 8));
#pragma unroll
      for (int ni = 0; ni < 4; ++ni) wf[ks][ni] = *(const bf16x8*)(Bb + (wn * 64 + ni * 16 + fr) * 64 + (((ks * 4 + fq) ^ rsw) * 8));
    }
    ISSUE(Ai, Bi, sAi, sBi, vAi, vBi, tk, st2);
#pragma unroll
    for (int ks = 0; ks < 2; ++ks)
#pragma unroll
      for (int ni = 0; ni < 4; ++ni)
#pragma unroll
        for (int mi = 0; mi < 4; ++mi)
          acc[ni][mi] = __builtin_amdgcn_mfma_f32_16x16x32_bf16(wf[ks][ni], tf[ks][mi], acc[ni][mi], 0, 0, 0);
    if constexpr (WIDE) {
      __builtin_amdgcn_sched_group_barrier(0x100, 8, 0);
#pragma unroll
      for (int i = 0; i < 6; ++i) {
        __builtin_amdgcn_sched_group_barrier(0x008, 2, 0);
        __builtin_amdgcn_sched_group_barrier(0x020, 1, 0);
      }
#pragma unroll
      for (int i = 0; i < 4; ++i) {
        __builtin_amdgcn_sched_group_barrier(0x008, 1, 0);
        __builtin_amdgcn_sched_group_barrier(0x100, 2, 0);
      }
      __builtin_amdgcn_sched_group_barrier(0x008, 16, 0);
    }
    st = (st == 2) ? 0 : st + 1;
    st2 = (st2 == 2) ? 0 : st2 + 1;
  }
  } else {
    bf16x8 ctf[4], cwf[4];
#pragma unroll
    for (int i = 0; i < 4; ++i) { ctf[i] = bf16x8{0, 0, 0, 0, 0, 0, 0, 0}; cwf[i] = bf16x8{0, 0, 0, 0, 0, 0, 0, 0}; }
#pragma unroll 1
  for (int kt = 0; kt < nkt; ++kt) {
    if (kt == 0 && !first) asm volatile("s_waitcnt vmcnt(0)" ::: "memory");
    else asm volatile("s_waitcnt vmcnt(6)" ::: "memory");
    RAW_BARRIER();
    const bool own = (kt + 2 < nkt);
    const bool fromn = !own && has_next;
    const int tk = own ? kt + 2 : (fromn ? kt + 2 - nkt : nkt - 1);
    const char* Ai = fromn ? Acn : Acc;
    const char* Bi = fromn ? Bcn : Bcc;
    const size_t sAi = fromn ? sAn : sAc, sBi = fromn ? sBn : sBc;
    const int ldai_ = fromn ? nxt.lda : cur.lda, ldbi_ = fromn ? nxt.ldb : cur.ldb;
    const unsigned vAi = (unsigned)((rr * ldai_ + lc8) * 2), vBi = (unsigned)((rr * ldbi_ + lc8) * 2);
    const bfu* Ab = (const bfu*)((const char*)lds + st * STGB);
    const bfu* Bb = Ab + 256 * 64;
    ISSUE(Ai, Bi, sAi, sBi, vAi, vBi, tk, st2);
#pragma unroll
    for (int ni = 0; ni < 4; ++ni)
#pragma unroll
      for (int mi = 0; mi < 4; ++mi)
        acc[ni][mi] = __builtin_amdgcn_mfma_f32_16x16x32_bf16(cwf[ni], ctf[mi], acc[ni][mi], 0, 0, 0);
    __builtin_amdgcn_sched_barrier(0);
    bf16x8 tf0[4], wf0[4];
#pragma unroll
    for (int mi = 0; mi < 4; ++mi) tf0[mi] = *(const bf16x8*)(Ab + (wm * 64 + mi * 16 + fr) * 64 + ((fq ^ rsw) * 8));
#pragma unroll
    for (int ni = 0; ni < 4; ++ni) wf0[ni] = *(const bf16x8*)(Bb + (wn * 64 + ni * 16 + fr) * 64 + ((fq ^ rsw) * 8));
#pragma unroll
    for (int ni = 0; ni < 4; ++ni)
#pragma unroll
      for (int mi = 0; mi < 4; ++mi)
        acc[ni][mi] = __builtin_amdgcn_mfma_f32_16x16x32_bf16(wf0[ni], tf0[mi], acc[ni][mi], 0, 0, 0);
    bf16x8 tf1[4], wf1[4];
#pragma unroll
    for (int mi = 0; mi < 4; ++mi) tf1[mi] = *(const bf16x8*)(Ab + (wm * 64 + mi * 16 + fr) * 64 + (((4 + fq) ^ rsw) * 8));
#pragma unroll
    for (int ni = 0; ni < 4; ++ni) wf1[ni] = *(const bf16x8*)(Bb + (wn * 64 + ni * 16 + fr) * 64 + (((4 + fq) ^ rsw) * 8));
#pragma unroll
    for (int i = 0; i < 4; ++i) { ctf[i] = tf1[i]; cwf[i] = wf1[i]; }
    st = (st == 2) ? 0 : st + 1;
    st2 = (st2 == 2) ? 0 : st2 + 1;
  }
#pragma unroll
    for (int ni = 0; ni < 4; ++ni)
#pragma unroll
      for (int mi = 0; mi < 4; ++mi)
        acc[ni][mi] = __builtin_amdgcn_mfma_f32_16x16x32_bf16(cwf[ni], ctf[mi], acc[ni][mi], 0, 0, 0);
  }
  rg.st = st; rg.st2 = st2;
  if (!has_next) {
    asm volatile("s_waitcnt vmcnt(0)" ::: "memory");
    RAW_BARRIER();
  }
#undef ISSUE
}

DEVI void gemm16s(f32x4 (&acc)[4][8], const GUnit& cur, const GUnit& nxt, bool has_next, bool first, int& stg, bfu* lds) {
  constexpr int STGB = 512 * 128;
  const int tid = get_tid512(), lane = tid & 63, wid = tid >> 6, wm = wid >> 2, wn = wid & 3;
  const int fr = lane & 15, fq = lane >> 4;
  const int rsw = fr >> 1;
  const int lc = (tid & 7) ^ ((tid >> 4) & 7);
  const int rr = tid >> 3;
  const int lc8 = lc * 8;
  char* lbase = (char*)lds + __builtin_amdgcn_readfirstlane(wid) * 1024;
  const int nkt = cur.nkt;
#define ISSUE16(AC, BC, SA, SB, VA, VB, KT, ST)                                    \
  do {                                                                             \
    char* sb = lbase + (ST) * STGB;                                                \
    const size_t ko = (size_t)(KT) * 128;                                          \
    glds16((AC) + ko + (VA), sb);                                                  \
    glds16((AC) + (SA) + ko + (VA), sb + 8192);                                    \
    glds16((AC) + 2 * (SA) + ko + (VA), sb + 16384);                               \
    glds16((AC) + 3 * (SA) + ko + (VA), sb + 24576);                               \
    glds16((BC) + ko + (VB), sb + 32768);                                          \
    glds16((BC) + (SB) + ko + (VB), sb + 40960);                                   \
    glds16((BC) + 2 * (SB) + ko + (VB), sb + 49152);                               \
    glds16((BC) + 3 * (SB) + ko + (VB), sb + 57344);                               \
  } while (0)
  const char* Acc = (const char*)cur.A;
  const char* Bcc = (const char*)cur.B;
  const size_t sAc = (size_t)64 * cur.lda * 2, sBc = (size_t)64 * cur.ldb * 2;
  const char* Acn = (const char*)nxt.A;
  const char* Bcn = (const char*)nxt.B;
  const size_t sAn = (size_t)64 * nxt.lda * 2, sBn = (size_t)64 * nxt.ldb * 2;
  int st = stg;
  if (first) {
    asm volatile("s_waitcnt vmcnt(0)" ::: "memory");
    ISSUE16(Acc, Bcc, sAc, sBc, (unsigned)((rr * cur.lda + lc8) * 2), (unsigned)((rr * cur.ldb + lc8) * 2), 0, st);
  }
#define G16_HEAD()                                                                                         \
    asm volatile("s_waitcnt vmcnt(0)" ::: "memory");     \
    RAW_BARRIER();                                        \
    const bool own = (kt + 1 < nkt);                                                                          \
    const bool fromn = !own && has_next;                                                                      \
    const int tk = own ? kt + 1 : (fromn ? 0 : nkt - 1);        \
    const char* Ai = fromn ? Acn : Acc;                                                                       \
    const char* Bi = fromn ? Bcn : Bcc;                                                                       \
    const size_t sAi = fromn ? sAn : sAc, sBi = fromn ? sBn : sBc;                                            \
    const int ldai_ = fromn ? nxt.lda : cur.lda, ldbi_ = fromn ? nxt.ldb : cur.ldb;                           \
    const unsigned vAi = (unsigned)((rr * ldai_ + lc8) * 2), vBi = (unsigned)((rr * ldbi_ + lc8) * 2);         \
    const bfu* Ab = (const bfu*)((const char*)lds + st * STGB);                                               \
    const bfu* Bb = Ab + 256 * 64;
#define G16_RD(TF, WF, KS)                                                                                                  \
    _Pragma("unroll") for (int mi = 0; mi < 8; ++mi)                                                                         \
      TF[mi] = *(const bf16x8*)(Ab + (wm * 128 + mi * 16 + fr) * 64 + ((((KS) * 4 + fq) ^ rsw) * 8));                        \
    _Pragma("unroll") for (int ni = 0; ni < 4; ++ni)                                                                         \
      WF[ni] = *(const bf16x8*)(Bb + (wn * 64 + ni * 16 + fr) * 64 + ((((KS) * 4 + fq) ^ rsw) * 8));
#define G16_MM(TF, WF)                                                                                        \
    _Pragma("unroll") for (int ni = 0; ni < 4; ++ni)                                                           \
      _Pragma("unroll") for (int mi = 0; mi < 8; ++mi)                                                         \
        acc[ni][mi] = __builtin_amdgcn_mfma_f32_16x16x32_bf16(WF[ni], TF[mi], acc[ni][mi], 0, 0, 0);
  const int grp = __builtin_amdgcn_readfirstlane(wid >> 2);
  if (grp == 0) {
#pragma unroll 1
    for (int kt = 0; kt < nkt; ++kt) {
      G16_HEAD()
      bf16x8 tf0[8], wf0[4];
      G16_RD(tf0, wf0, 0)
      ISSUE16(Ai, Bi, sAi, sBi, vAi, vBi, tk, st ^ 1);
      G16_MM(tf0, wf0)
      bf16x8 tf1[8], wf1[4];
      G16_RD(tf1, wf1, 1)
      G16_MM(tf1, wf1)
      __builtin_amdgcn_sched_group_barrier(0x100, 12, 0);
#pragma unroll
      for (int i = 0; i < 8; ++i) {
        __builtin_amdgcn_sched_group_barrier(0x008, 3, 0);
        __builtin_amdgcn_sched_group_barrier(0x020, 1, 0);
      }
#pragma unroll
      for (int i = 0; i < 12; ++i) {
        __builtin_amdgcn_sched_group_barrier(0x008, 1, 0);
        __builtin_amdgcn_sched_group_barrier(0x100, 1, 0);
      }
      __builtin_amdgcn_sched_group_barrier(0x008, 28, 0);
      st ^= 1;
    }
  } else {
    bf16x8 ctf[8], cwf[4];
#pragma unroll
    for (int mi = 0; mi < 8; ++mi) ctf[mi] = bf16x8{0, 0, 0, 0, 0, 0, 0, 0};
#pragma unroll
    for (int ni = 0; ni < 4; ++ni) cwf[ni] = bf16x8{0, 0, 0, 0, 0, 0, 0, 0};
#pragma unroll 1
    for (int kt = 0; kt < nkt; ++kt) {
      G16_HEAD()
      ISSUE16(Ai, Bi, sAi, sBi, vAi, vBi, tk, st ^ 1);
      G16_MM(ctf, cwf)
      bf16x8 tf0[8], wf0[4];
      G16_RD(tf0, wf0, 0)
      G16_MM(tf0, wf0)
      bf16x8 tf1[8], wf1[4];
      G16_RD(tf1, wf1, 1)
#pragma unroll
      for (int mi = 0; mi < 8; ++mi) ctf[mi] = tf1[mi];
#pragma unroll
      for (int ni = 0; ni < 4; ++ni) cwf[ni] = wf1[ni];
#pragma unroll
      for (int i = 0; i < 8; ++i) {
        __builtin_amdgcn_sched_group_barrier(0x008, 4, 0);
        __builtin_amdgcn_sched_group_barrier(0x020, 1, 0);
      }
      __builtin_amdgcn_sched_group_barrier(0x100, 12, 0);
#pragma unroll
      for (int i = 0; i < 12; ++i) {
        __builtin_amdgcn_sched_group_barrier(0x008, 2, 0);
        __builtin_amdgcn_sched_group_barrier(0x100, 1, 0);
      }
      __builtin_amdgcn_sched_group_barrier(0x008, 8, 0);
      st ^= 1;
    }
    G16_MM(ctf, cwf)
  }
#undef G16_HEAD
#undef G16_RD
#undef G16_MM
  stg = st;
  if (!has_next) {
    asm volatile("s_waitcnt vmcnt(0)" ::: "memory");
    RAW_BARRIER();
  }
#undef ISSUE16
}

DEVI void zero_acc8(f32x4 (&acc)[4][8]) {
#pragma unroll
  for (int a = 0; a < 4; ++a)
#pragma unroll
    for (int b = 0; b < 8; ++b) acc[a][b] = f32x4{0.f, 0.f, 0.f, 0.f};
}

DEVI bool tile_map(int it, int NT, int& mt, int& nt) {
  const int x = blockIdx.x & 7, j = blockIdx.x >> 3, nxb = gridDim.x >> 3;
  const int q = it * nxb + j;
  if (q >= 8 * NT) return false;
  const int band = q / (4 * NT), r = q - band * 4 * NT;
  nt = r >> 2;
  mt = x * 8 + band * 4 + (r & 3);
  return true;
}

template <int NI>
DEVI void zero_acc(f32x4 (&acc)[NI][4]) {
#pragma unroll
  for (int a = 0; a < NI; ++a)
#pragma unroll
    for (int b = 0; b < 4; ++b) acc[a][b] = f32x4{0.f, 0.f, 0.f, 0.f};
}

DEVI void cvt_tile(const float* __restrict__ src, int ld_src, int col0, int valid, bfu* __restrict__ dst, int ld_dst,
                   char* lds_raw, const float* __restrict__ gain = nullptr) {
  float* tile = (float*)lds_raw;
  const int tid = get_tid();
  __syncthreads();
#pragma unroll
  for (int i = 0; i < 4; ++i) {
    int id = tid + 256 * i;
    int row = id >> 4, c4 = id & 15;
    float4 v = make_float4(0.f, 0.f, 0.f, 0.f);
    if (c4 * 4 < valid) v = *(const float4*)(src + (long)row * ld_src + col0 + c4 * 4);
    if (gain) { const float gk = gain[row]; v.x *= gk; v.y *= gk; v.z *= gk; v.w *= gk; }
    float* t = tile + row * 65 + c4 * 4;
    t[0] = v.x; t[1] = v.y; t[2] = v.z; t[3] = v.w;
  }
  __syncthreads();
#pragma unroll
  for (int i = 0; i < 2; ++i) {
    int id = tid + 256 * i;
    int n = id >> 3, kc = id & 7;
    uint4 o;
    o.x = pack2(tile[(kc * 8 + 0) * 65 + n], tile[(kc * 8 + 1) * 65 + n]);
    o.y = pack2(tile[(kc * 8 + 2) * 65 + n], tile[(kc * 8 + 3) * 65 + n]);
    o.z = pack2(tile[(kc * 8 + 4) * 65 + n], tile[(kc * 8 + 5) * 65 + n]);
    o.w = pack2(tile[(kc * 8 + 6) * 65 + n], tile[(kc * 8 + 7) * 65 + n]);
    *(uint4*)(dst + (long)n * ld_dst + kc * 8) = o;
  }
}

constexpr int P1_CVT = 4484;
constexpr int P1_BIAS = 2;
constexpr int P1_RMS = 1024;
constexpr int P1_ITEMS = P1_CVT + P1_BIAS + P1_RMS;

DEVI void rms_rows(const float* __restrict__ x, float* __restrict__ ssq, bfu* __restrict__ dst, int item) {
  const int lane = get_tid() & 63, wid = get_tid() >> 6;
  float4 v[4][4];
#pragma unroll
  for (int r = 0; r < 4; ++r) {
    const float4* xr = (const float4*)(x + ((long)item * 16 + wid * 4 + r) * 1024);
#pragma unroll
    for (int i = 0; i < 4; ++i) v[r][i] = xr[lane + 64 * i];
  }
#pragma unroll
  for (int r = 0; r < 4; ++r) {
    long row = (long)item * 16 + wid * 4 + r;
    float ss = 0.f;
#pragma unroll
    for (int i = 0; i < 4; ++i) ss += v[r][i].x * v[r][i].x + v[r][i].y * v[r][i].y + v[r][i].z * v[r][i].z + v[r][i].w * v[r][i].w;
    ss = wave_sum(ss);
    if (lane == 0) *(float4*)(ssq + row * 4) = make_float4(ss, 0.f, 0.f, 0.f);
#pragma unroll
    for (int i = 0; i < 4; ++i) {
      uint2 o;
      o.x = pack2(v[r][i].x, v[r][i].y);
      o.y = pack2(v[r][i].z, v[r][i].w);
      *(uint2*)(dst + row * LDX + (lane + 64 * i) * 4) = o;
    }
  }
}
DEVI float row_ssq(const float* __restrict__ ssq, long m) {
  const float4 q = *(const float4*)(ssq + m * 4);
  float v = (q.x + q.y) + (q.z + q.w);
  asm volatile("" : "+v"(v));
  return v;
}
DEVI float ssq_rstd(float v) { return rsqrtf(v * (1.f / 1024.f) + 1e-6f); }
DEVI float* stage_rstd(const float* __restrict__ ssq, int m0, int it, char* lds) {
  float* rsS = (float*)(lds + 131072 + 8192) + (it & 1) * 256;
  const int t = get_tid512();
  if (t < 256) {
    const float4 q = *(const float4*)(ssq + (long)(m0 + t) * 4);
    rsS[t] = ssq_rstd((q.x + q.y) + (q.z + q.w));
  }
  return rsS;
}

DEVI void phase1(const Params& p, int l, char* lds) {
  char* ws = p.ws;
  const float* xin = (l == 0) ? p.in[0] : p.out;
  const int n_items = P1_CVT + P1_BIAS + (l == 0 ? P1_RMS : 0);
  for (int item = vblk(); item < n_items; item += vgrid()) {
    int i = item;
    if (i < P1_CVT) {
      if (i < 768) {
        int kt = i / 48, nt = i % 48;
        int col0, valid;
        if (nt < 24) { col0 = nt * 64; valid = 64; }
        else if (nt < 44) { col0 = nt * 64 + 12; valid = 64; }
        else if (nt == 44) { col0 = 1536; valid = 12; }
        else { col0 = 0; valid = 0; }
        cvt_tile(p.in[2] + (long)l * 1024 * 2828 + (long)kt * 64 * 2828, 2828, col0, valid,
                 (bfu*)(ws + OFF_WIN) + (long)nt * 64 * LDX + kt * 64, LDX, lds, p.in[1] + l * 1024 + kt * 64);
        continue;
      }
      i -= 768;
      if (i < 1024) {
        int kt = i / 64, nt = i % 64;
        cvt_tile(p.in[18] + (long)l * 1024 * 4096 + (long)kt * 64 * 4096, 4096, nt * 64, 64,
                 (bfu*)(ws + OFF_WGATE) + (long)nt * 64 * LDX + kt * 64, LDX, lds, p.in[1] + l * 1024 + kt * 64);
        continue;
      }
      i -= 1024;
      if (i < 256) {
        int bb = i / 64, r = i % 64, kt = r / 16, nt = r % 16;
        cvt_tile(p.in[17] + ((long)(l * 4 + bb) * 256 + kt * 64) * 1024, 1024, nt * 64, 64,
                 (bfu*)(ws + OFF_WBR) + ((long)bb * 1024 + nt * 64) * LDBR + kt * 64, LDBR, lds);
        continue;
      }
      i -= 256;
      if (i < 256) {
        int kt = i / 16, nt = i % 16;
        cvt_tile(p.in[20] + (long)l * 1024 * 1024 + (long)kt * 64 * 1024, 1024, nt * 64, 64,
                 (bfu*)(ws + OFF_WOUT) + (long)nt * 64 * LDX + kt * 64, LDX, lds);
        continue;
      }
      i -= 256;
      if (i < 1024) {
        int kt = i / 64, nt = i % 64;
        cvt_tile(p.in[22] + (long)l * 1024 * 4096 + (long)kt * 64 * 4096, 4096, nt * 64, 64,
                 (bfu*)(ws + OFF_WM1) + (long)nt * 64 * LDX + kt * 64, LDX, lds, p.in[21] + l * 1024 + kt * 64);
        continue;
      }
      i -= 1024;
      if (i < 1024) {
        int kt = i / 16, nt = i % 16;
        cvt_tile(p.in[23] + (long)l * 4096 * 1024 + (long)kt * 64 * 1024, 1024, nt * 64, 64,
                 (bfu*)(ws + OFF_WM2) + (long)nt * 64 * LDH + kt * 64, LDH, lds);
        continue;
      }
      i -= 1024;
      if (i < 128) {
        int kv = i / 64, r = i % 64, kt = r / 2, nt = r % 2;
        cvt_tile(p.in[10] + ((long)(l * 2 + kv) * 2048 + kt * 64) * 128, 128, nt * 64, 64,
                 (bfu*)(ws + OFF_CW1) + ((long)kv * 128 + nt * 64) * 2048 + kt * 64, 2048, lds);
        continue;
      }
      i -= 128;
      {
        int kv = i / 2, kt = i % 2;
        cvt_tile(p.in[11] + ((long)(l * 2 + kv) * 128 + kt * 64) * 64, 64, 0, 64,
                 (bfu*)(ws + OFF_CW2) + ((long)kv * 64) * 128 + kt * 64, 128, lds);
        continue;
      }
    }
    i -= P1_CVT;
    if (i < P1_BIAS) {
      int kv = i;
      const float* pe = p.in[9] + (long)(l * 2 + kv) * 2048;
      bfu* dst = (bfu*)(ws + OFF_PEB) + (long)kv * 32 * LDP;
      for (int f = get_tid(); f < 2048; f += 256) dst[(f >> 6) * LDP + (f & 63)] = f2bf(pe[f]);
      continue;
    }
    i -= P1_BIAS;
    rms_rows(xin, (float*)(ws + OFF_SSQA), (bfu*)(ws + OFF_XN), i);
  }
}

DEVI void phase2(const Params& p, int l, char* lds) {
  const bfu* xn = (const bfu*)(p.ws + OFF_XN);
  const bfu* wT = (const bfu*)(p.ws + OFF_WIN);
  bfu* proj = (bfu*)(p.ws + OFF_PROJ);
  const int lane = get_tid512() & 63, wid = get_tid512() >> 6, wm = wid >> 2, wn = wid & 3, fr = lane & 15, fq = lane >> 4;
  int stg = 0;
  int mt, nt;
  bool have = tile_map(0, 12, mt, nt);
  for (int it = 0; have; ++it) {
    int mt2 = 0, nt2 = 0;
    const bool have2 = tile_map(it + 1, 12, mt2, nt2);
    const int m0 = mt * 256, n0 = nt * 256;
    const GUnit cur{xn + (long)m0 * LDX, wT + (long)n0 * LDX, LDX, LDX, 16};
    const GUnit nxt{xn + (long)mt2 * 256 * LDX, wT + (long)nt2 * 256 * LDX, LDX, LDX, 16};
    const float* rsS = stage_rstd((const float*)(p.ws + OFF_SSQA), m0, it, lds);
    f32x4 acc[4][8];
    zero_acc8(acc);
    gemm16s(acc, cur, nxt, have2, it == 0, stg, (bfu*)lds);
    const int nt_cur = nt;
    mt = mt2; nt = nt2; have = have2;
#pragma unroll
    for (int mi = 0; mi < 8; ++mi) {
      const float rs = rsS[wm * 128 + mi * 16 + fr];
#pragma unroll
      for (int ni = 0; ni < 4; ++ni) acc[ni][mi] *= rs;
    }
    const bool do_gelu = (n0 < 512);
    const int kind = (nt_cur == 2) ? 1 : ((nt_cur == 4 && wn < 2) ? 2 : ((nt_cur == 5 && wn < 2) ? 3 : 0));
    if (kind) {
      const float* gain = (kind == 1) ? (p.in[7] + l * 64) : (p.in[8] + (l * 3 + (kind == 2 ? 1 : 2)) * 64);
      const float mul = (kind == 1) ? 0.125f * 1.4426950408889634f : 1.f;
#pragma unroll
      for (int mi = 0; mi < 8; ++mi) {
        float ss = 0.f;
#pragma unroll
        for (int ni = 0; ni < 4; ++ni)
#pragma unroll
          for (int j = 0; j < 4; ++j) ss += acc[ni][mi][j] * acc[ni][mi][j];
        ss += __shfl_xor(ss, 16);
        ss += __shfl_xor(ss, 32);
        const float rstd = rsqrtf(ss * (1.f / 64.f) + 1e-6f) * mul;
#pragma unroll
        for (int ni = 0; ni < 4; ++ni) {
          float4 gg = *(const float4*)(gain + ni * 16 + fq * 4);
          acc[ni][mi][0] *= rstd * gg.x; acc[ni][mi][1] *= rstd * gg.y; acc[ni][mi][2] *= rstd * gg.z; acc[ni][mi][3] *= rstd * gg.w;
        }
      }
    }
#pragma unroll
    for (int ni = 0; ni < 4; ++ni)
#pragma unroll
      for (int mi = 0; mi < 8; ++mi) {
        f32x4 v = acc[ni][mi];
        if (do_gelu) { v[0] = gelu_f(v[0]); v[1] = gelu_f(v[1]); v[2] = gelu_f(v[2]); v[3] = gelu_f(v[3]); }
        int n = n0 + wn * 64 + ni * 16 + fq * 4;
        int m = m0 + wm * 128 + mi * 16 + fr;
        store_bf4(proj + (long)m * LDP + n, v);
      }
  }
}

DEVI void compress_item(const Params& p, int l, int ci, char* lds) {
  const int hf = vhalf();
  const bool writer = (hf == 0);
  const bfu* proj = (const bfu*)(p.ws + OFF_PROJ);
  const int kv = ci >> 4, bh = ci & 15, b = bh >> 1, h = bh & 1;
  const int lane = get_tid() & 63, wid = get_tid() >> 6, wm = wid >> 1, wn = wid & 1, fr = lane & 15, fq = lane >> 4;
  bfu* chid = (bfu*)(p.ws + OFF_CHID) + (long)ci * 128 * 128;
  {
    f32x4 acc[4][4];
    zero_acc<4>(acc);
    const bfu* abase = proj + (long)(b * SEQ) * LDP + (kv ? C_VC : C_KC) + h * 64;
    const bfu* peb = (const bfu*)(p.ws + OFF_PEB) + (long)kv * 32 * LDP;
    const long k0 = (long)hf * 16;
    gemm_core<128>(acc, [&](int r) { return (r < 127 ? abase + (long)(r * 16) * LDP : peb) + k0 * LDP; }, (long)LDP,
                   (const bfu*)(p.ws + OFF_CW1) + (long)kv * 128 * 2048 + k0 * 64, 2048, 16, (bfu*)lds);
    {
      float* xch = (float*)(lds + (hf == 0 ? LDS_HALF : 0));
      if (hf == 1) {
#pragma unroll
        for (int ni = 0; ni < 4; ++ni)
#pragma unroll
          for (int mi = 0; mi < 4; ++mi)
#pragma unroll
            for (int j = 0; j < 4; ++j) xch[((ni * 4 + mi) * 4 + j) * 256 + get_tid()] = acc[ni][mi][j];
      }
      __syncthreads();
      if (hf == 0) {
#pragma unroll
        for (int ni = 0; ni < 4; ++ni)
#pragma unroll
          for (int mi = 0; mi < 4; ++mi)
#pragma unroll
            for (int j = 0; j < 4; ++j) acc[ni][mi][j] += xch[((ni * 4 + mi) * 4 + j) * 256 + get_tid()];
      }
      __syncthreads();
    }
    float* biasS = (float*)lds;
    if (wm == 1 && fr == 15) {
#pragma unroll
      for (int ni = 0; ni < 4; ++ni)
#pragma unroll
        for (int j = 0; j < 4; ++j) biasS[wn * 64 + ni * 16 + fq * 4 + j] = acc[ni][3][j];
    }
    __syncthreads();
#pragma unroll
    for (int ni = 0; ni < 4; ++ni)
#pragma unroll
      for (int mi = 0; mi < 4; ++mi) {
        int e = wn * 64 + ni * 16 + fq * 4;
        int m = wm * 64 + mi * 16 + fr;
        f32x4 v = acc[ni][mi];
        float4 bb = *(const float4*)(biasS + e);
        if (m == 127) bb = make_float4(0.f, 0.f, 0.f, 0.f);
        v[0] = gelu_f(v[0] + bb.x); v[1] = gelu_f(v[1] + bb.y); v[2] = gelu_f(v[2] + bb.z); v[3] = gelu_f(v[3] + bb.w);
        if (writer) store_bf4(chid + m * 128 + e, v);
      }
  }
  __threadfence();
  __syncthreads();
  float* outs = (float*)lds;
  {
    f32x4 acc2[2][4];
    zero_acc<2>(acc2);
    gemm_core<64>(acc2, [&](int r) { return (const bfu*)chid + r * 128; }, 64,
                  (const bfu*)(p.ws + OFF_CW2) + (long)kv * 64 * 128, 128, 2, (bfu*)lds);
#pragma unroll
    for (int ni = 0; ni < 2; ++ni)
#pragma unroll
      for (int mi = 0; mi < 4; ++mi) {
        int d = wn * 32 + ni * 16 + fq * 4;
        int m = wm * 64 + mi * 16 + fr;
#pragma unroll
        for (int j = 0; j < 4; ++j) outs[m * 65 + d + j] = acc2[ni][mi][j];
      }
  }
  __syncthreads();
  if (kv == 0) {
    if (writer && get_tid() < 128) {
      int n = get_tid();
      float ss = 0.f;
      for (int d = 0; d < 64; ++d) { float v = outs[n * 65 + d]; ss += v * v; }
      float rstd = rsqrtf(ss * (1.f / 64.f) + 1e-6f);
      const float* kg = p.in[8] + (long)(l * 3 + 0) * 64;
      bfu* dst = (bfu*)(p.ws + OFF_KCMP) + ((long)(b * 2 + h) * 128 + n) * 64;
      for (int d = 0; d < 64; d += 2)
        *(unsigned*)(dst + d) = pack2(outs[n * 65 + d] * rstd * kg[d], outs[n * 65 + d + 1] * rstd * kg[d + 1]);
    }
  } else {
    bfu* dst = (bfu*)(p.ws + OFF_VCT) + (long)(b * 2 + h) * 64 * 128;
    for (int id = get_tid(); writer && id < 64 * 128; id += 256) {
      int d = id >> 7, n = id & 127;
      dst[d * 128 + n] = f2bf(outs[n * 65 + d]);
    }
  }
  __syncthreads();
}

DEVI void gmlp_item(const Params& p, int l, int idx, char* lds) {
  const bfu* proj = (const bfu*)(p.ws + OFF_PROJ);
  bfu* y = (bfu*)(p.ws + OFF_Y);
  const int g = idx & 3, chunk = (idx >> 2) & 15, b = idx >> 6;
  const long tok0 = (long)b * SEQ + chunk * 128;
  const int tid = get_tid(), lane = tid & 63, wid = tid >> 6, fr = lane & 15, fq = lane >> 4;
  constexpr int GS = 136;
  bfu* vlnT = (bfu*)lds;
  bfu* wsm = vlnT + 64 * GS;
  float* stats = (float*)(wsm + 128 * GS);
  __syncthreads();
  {
    const int t = tid >> 1, h2 = tid & 1;
    const uint4* src = (const uint4*)(proj + (tok0 + t) * LDP + C_GV + h2 * 128);
    uint4 u[16];
#pragma unroll
    for (int i = 0; i < 16; ++i) u[i] = src[i];
    float sm = 0.f;
#pragma unroll
    for (int i = 0; i < 16; ++i)
      sm += lo2f(u[i].x) + hi2f(u[i].x) + lo2f(u[i].y) + hi2f(u[i].y) + lo2f(u[i].z) + hi2f(u[i].z) + lo2f(u[i].w) + hi2f(u[i].w);
    sm += __shfl_xor(sm, 1);
    const float mean = sm * (1.f / 256.f);
    float q = 0.f;
#pragma unroll
    for (int i = 0; i < 16; ++i) {
      float d;
      d = lo2f(u[i].x) - mean; q += d * d; d = hi2f(u[i].x) - mean; q += d * d;
      d = lo2f(u[i].y) - mean; q += d * d; d = hi2f(u[i].y) - mean; q += d * d;
      d = lo2f(u[i].z) - mean; q += d * d; d = hi2f(u[i].z) - mean; q += d * d;
      d = lo2f(u[i].w) - mean; q += d * d; d = hi2f(u[i].w) - mean; q += d * d;
    }
    q += __shfl_xor(q, 1);
    if (h2 == 0) { stats[t * 2] = mean; stats[t * 2 + 1] = rsqrtf(q * (1.f / 256.f) + 1e-5f); }
  }
  const float* wsg = p.in[5] + (long)(l * 4 + g) * 128 * 128;
#pragma unroll
  for (int i = 0; i < 16; ++i) {
    int id = tid + 256 * i;
    int t = id >> 5, s4 = (id & 31) * 4;
    float4 w = *(const float4*)(wsg + t * 128 + s4);
    if (s4 + 0 > t) w.x = 0.f;
    if (s4 + 1 > t) w.y = 0.f;
    if (s4 + 2 > t) w.z = 0.f;
    if (s4 + 3 > t) w.w = 0.f;
    uint2 o; o.x = pack2(w.x, w.y); o.y = pack2(w.z, w.w);
    *(uint2*)(wsm + t * GS + s4) = o;
  }
  __syncthreads();
  const float* lg = p.in[3] + l * 256 + g * 64;
  const float* lb = p.in[4] + l * 256 + g * 64;
#pragma unroll
  for (int i = 0; i < 8; ++i) {
    int id = tid + 256 * i;
    int t = id & 127, c4 = (id >> 7) * 4;
    uint2 u = *(const uint2*)(proj + (tok0 + t) * LDP + C_GV + g * 64 + c4);
    float mean = stats[t * 2], rstd = stats[t * 2 + 1];
    float4 gg = *(const float4*)(lg + c4), bb = *(const float4*)(lb + c4);
    vlnT[(c4 + 0) * GS + t] = f2bf((lo2f(u.x) - mean) * rstd * gg.x + bb.x);
    vlnT[(c4 + 1) * GS + t] = f2bf((hi2f(u.x) - mean) * rstd * gg.y + bb.y);
    vlnT[(c4 + 2) * GS + t] = f2bf((lo2f(u.y) - mean) * rstd * gg.z + bb.z);
    vlnT[(c4 + 3) * GS + t] = f2bf((hi2f(u.y) - mean) * rstd * gg.w + bb.w);
  }
  __syncthreads();
  f32x4 acc[4][2];
#pragma unroll
  for (int a = 0; a < 4; ++a)
#pragma unroll
    for (int c = 0; c < 2; ++c) acc[a][c] = f32x4{0.f, 0.f, 0.f, 0.f};
  const int nks = (wid * 32 + 31) / 32 + 1;
  for (int ks = 0; ks < nks; ++ks) {
    bf16x8 af[4], tf[2];
#pragma unroll
    for (int cs = 0; cs < 4; ++cs) af[cs] = *(const bf16x8*)(vlnT + (cs * 16 + fr) * GS + ks * 32 + fq * 8);
#pragma unroll
    for (int ts = 0; ts < 2; ++ts) tf[ts] = *(const bf16x8*)(wsm + ((wid * 2 + ts) * 16 + fr) * GS + ks * 32 + fq * 8);
#pragma unroll
    for (int cs = 0; cs < 4; ++cs)
#pragma unroll
      for (int ts = 0; ts < 2; ++ts) acc[cs][ts] = __builtin_amdgcn_mfma_f32_16x16x32_bf16(af[cs], tf[ts], acc[cs][ts], 0, 0, 0);
  }
  const float* bsg = p.in[6] + (long)(l * 4 + g) * 128;
#pragma unroll
  for (int ts = 0; ts < 2; ++ts) {
    int t = (wid * 2 + ts) * 16 + fr;
    float bsv = bsg[t];
#pragma unroll
    for (int cs = 0; cs < 4; ++cs) {
      int c = cs * 16 + fq * 4;
      uint2 u = *(const uint2*)(proj + (tok0 + t) * LDP + C_GU + g * 64 + c);
      f32x4 v;
      v[0] = lo2f(u.x) * (acc[cs][ts][0] + bsv);
      v[1] = hi2f(u.x) * (acc[cs][ts][1] + bsv);
      v[2] = lo2f(u.y) * (acc[cs][ts][2] + bsv);
      v[3] = hi2f(u.y) * (acc[cs][ts][3] + bsv);
      store_bf4(y + (tok0 + t) * LDX + g * 64 + c, v);
    }
  }
}

DEVI void conf_item(const Params& p, int l, int idx, char* lds) {
  const bfu* proj = (const bfu*)(p.ws + OFF_PROJ);
  bfu* y = (bfu*)(p.ws + OFF_Y);
  const int b = idx >> 6, tile = idx & 63;
  const int t0 = tile * 32;
  const int tid = get_tid(), lane = tid & 63, wid = tid >> 6;
  bfu* zt = (bfu*)lds;
  float* outt = (float*)(lds + 62 * 256 * 2);
  __syncthreads();
#pragma unroll
  for (int it8 = 0; it8 < 8; ++it8) {
    int id = tid + 256 * it8;
    if (id >= 62 * 32) break;
    int r = id >> 5, cc = id & 31;
    int tok = t0 - 30 + r;
    uint4 o = make_uint4(0, 0, 0, 0);
    if (tok >= 0) {
      const bfu* row = proj + ((long)b * SEQ + tok) * LDP;
      uint4 a = *(const uint4*)(row + C_CA + cc * 8);
      uint4 g = *(const uint4*)(row + C_CB + cc * 8);
      o.x = pack2(lo2f(a.x) * sigmoidf_(lo2f(g.x)), hi2f(a.x) * sigmoidf_(hi2f(g.x)));
      o.y = pack2(lo2f(a.y) * sigmoidf_(lo2f(g.y)), hi2f(a.y) * sigmoidf_(hi2f(g.y)));
      o.z = pack2(lo2f(a.z) * sigmoidf_(lo2f(g.z)), hi2f(a.z) * sigmoidf_(hi2f(g.z)));
      o.w = pack2(lo2f(a.w) * sigmoidf_(lo2f(g.w)), hi2f(a.w) * sigmoidf_(hi2f(g.w)));
    }
    *(uint4*)(zt + r * 256 + cc * 8) = o;
  }
  __syncthreads();
  {
    const int c = tid;
    float w[31];
    const float* cw = p.in[12] + (long)l * 31 * 256;
#pragma unroll
    for (int j = 0; j < 31; ++j) w[j] = cw[j * 256 + c];
    const float bias = p.in[13][l * 256 + c];
    for (int tg = 0; tg < 8; ++tg) {
      float o0 = bias, o1 = bias, o2 = bias, o3 = bias;
#pragma unroll
      for (int j = 0; j < 34; ++j) {
        float z = bf2f(zt[(tg * 4 + j) * 256 + c]);
        if (j < 31) o0 += w[j < 31 ? j : 0] * z;
        if (j >= 1 && j < 32) o1 += w[(j >= 1 && j < 32) ? j - 1 : 0] * z;
        if (j >= 2 && j < 33) o2 += w[(j >= 2 && j < 33) ? j - 2 : 0] * z;
        if (j >= 3) o3 += w[j >= 3 ? j - 3 : 0] * z;
      }
      outt[(tg * 4 + 0) * 256 + c] = o0;
      outt[(tg * 4 + 1) * 256 + c] = o1;
      outt[(tg * 4 + 2) * 256 + c] = o2;
      outt[(tg * 4 + 3) * 256 + c] = o3;
    }
  }
  __syncthreads();
  {
    float4 gg = ((const float4*)(p.in[14] + l * 256))[lane];
    float4 bb = ((const float4*)(p.in[15] + l * 256))[lane];
    for (int i = 0; i < 8; ++i) {
      int tt = wid * 8 + i;
      float4 v = *(const float4*)(outt + tt * 256 + lane * 4);
      float mean = wave_sum(v.x + v.y + v.z + v.w) * (1.f / 256.f);
      float d0 = v.x - mean, d1 = v.y - mean, d2 = v.z - mean, d3 = v.w - mean;
      float var = wave_sum(d0 * d0 + d1 * d1 + d2 * d2 + d3 * d3) * (1.f / 256.f);
      float rstd = rsqrtf(var + 1e-5f);
      float r0 = d0 * rstd * gg.x + bb.x, r1 = d1 * rstd * gg.y + bb.y, r2 = d2 * rstd * gg.z + bb.z, r3 = d3 * rstd * gg.w + bb.w;
      r0 *= sigmoidf_(r0); r1 *= sigmoidf_(r1); r2 *= sigmoidf_(r2); r3 *= sigmoidf_(r3);
      uint2 o; o.x = pack2(r0, r1); o.y = pack2(r2, r3);
      *(uint2*)(y + ((long)b * SEQ + t0 + tt) * LDX + 512 + lane * 4) = o;
    }
  }
}

DEVI void prepass_item(const Params& p, int l, int idx, char* lds) {
  const bfu* proj = (const bfu*)(p.ws + OFF_PROJ);
  const int b = idx >> 5, tile = idx & 31;
  const int tid = get_tid();
  const long tok0 = (long)b * SEQ + tile * 64;
  bfu* vt = (bfu*)lds;
  __syncthreads();
#pragma unroll
  for (int i = 0; i < 8; ++i) {
    int id = tid + 256 * i;
    int tokl = id >> 5, cc = id & 31;
    int col = (cc < 16) ? (C_VS + cc * 8) : (C_VW + (cc - 16) * 8);
    uint4 u = *(const uint4*)(proj + (tok0 + tokl) * LDP + col);
    *(uint4*)(vt + tokl * 264 + cc * 8) = u;
  }
  __syncthreads();
  for (int i = 0; i < 8; ++i) {
    int id = tid + 256 * i;
    int row = id & 255, ch = id >> 8;
    unsigned short e[8];
#pragma unroll
    for (int k = 0; k < 8; ++k) e[k] = vt[(ch * 8 + k) * 264 + row];
    uint4 o;
    o.x = (unsigned)e[0] | ((unsigned)e[1] << 16); o.y = (unsigned)e[2] | ((unsigned)e[3] << 16);
    o.z = (unsigned)e[4] | ((unsigned)e[5] << 16); o.w = (unsigned)e[6] | ((unsigned)e[7] << 16);
    int which = row >> 7, hd = row & 127;
    bfu* dst = (bfu*)(p.ws + (which ? OFF_VWT : OFF_VST)) + ((long)b * 128 + hd) * SEQ + tile * 64 + ch * 8;
    *(uint4*)dst = o;
  }
}

DEVI void sconv_item(const Params& p, int l, int idx) {
  const bfu* proj = (const bfu*)(p.ws + OFF_PROJ);
  bfu* y = (bfu*)(p.ws + OFF_Y);
  const int b = idx >> 5, tile = idx & 31;
  const float* sw = p.in[16] + (long)l * 3 * 256;
#pragma unroll 2
  for (int i = 0; i < 8; ++i) {
    int id = get_tid() + 256 * i;
    int tokl = id >> 5, cc = id & 31;
    int t = tile * 64 + tokl;
    float acc[8];
#pragma unroll
    for (int e = 0; e < 8; ++e) acc[e] = 0.f;
#pragma unroll
    for (int j = 0; j < 3; ++j) {
      int ts = t - 2 + j;
      if (ts >= 0) {
        const bfu* row = proj + ((long)b * SEQ + ts) * LDP;
        uint4 a = *(const uint4*)(row + C_SC + cc * 8);
        uint4 h = *(const uint4*)(row + C_SH + cc * 8);
        const float* w = sw + j * 256 + cc * 8;
        acc[0] += w[0] * lo2f(a.x) * lo2f(h.x); acc[1] += w[1] * hi2f(a.x) * hi2f(h.x);
        acc[2] += w[2] * lo2f(a.y) * lo2f(h.y); acc[3] += w[3] * hi2f(a.y) * hi2f(h.y);
        acc[4] += w[4] * lo2f(a.z) * lo2f(h.z); acc[5] += w[5] * hi2f(a.z) * hi2f(h.z);
        acc[6] += w[6] * lo2f(a.w) * lo2f(h.w); acc[7] += w[7] * hi2f(a.w) * hi2f(h.w);
      }
    }
    uint4 bb = *(const uint4*)(proj + ((long)b * SEQ + t) * LDP + C_SB + cc * 8);
    uint4 o;
    o.x = pack2(acc[0] * lo2f(bb.x), acc[1] * hi2f(bb.x));
    o.y = pack2(acc[2] * lo2f(bb.y), acc[3] * hi2f(bb.y));
    o.z = pack2(acc[4] * lo2f(bb.z), acc[5] * hi2f(bb.z));
    o.w = pack2(acc[6] * lo2f(bb.w), acc[7] * hi2f(bb.w));
    *(uint4*)(y + ((long)b * SEQ + t) * LDX + 768 + cc * 8) = o;
  }
}

constexpr int P3_CMP = 32, P3_GMLP = 512, P3_CONF = 512, P3_PRE = 256, P3_SCONV = 256;
constexpr int P3_ITEMS = P3_CMP + P3_GMLP + P3_CONF + P3_PRE + P3_SCONV;

DEVI void pull_extras(const Params& p, int l, char* lds, volatile int* nsa_cnt, int max_pulls);
DEVI void phase3a(const Params& p, int l, char* lds, bool rep, volatile int* nsa_cnt) {
  const int v = vblk(), nv = vgrid();
  const int wg = (int)blockIdx.x, nwg = (int)gridDim.x;
  if (wg < P3_CMP) {
    for (int i = wg; i < P3_CMP; i += nwg) compress_item(p, l, i, lds);
    if (nwg > 2 * P3_CMP) return;
  }
  const bool split = (nwg > 2 * P3_CMP);
  const int first = split ? v - 2 * P3_CMP : v, step = split ? nv - 2 * P3_CMP : nv;
  for (int item = first; item < P3_PRE; item += step) prepass_item(p, l, item, lds);
  if (split && !rep) pull_extras(p, l, lds, nsa_cnt, 1);
}

constexpr float NEGF = -1e30f;

DEVI void compute_S(f32x4 (&s)[2][4], const bf16x8 (&qf)[2][2], const bfu* Ks, int fr, int fq) {
#pragma unroll
  for (int g = 0; g < 2; ++g)
#pragma unroll
    for (int k = 0; k < 4; ++k) s[g][k] = f32x4{0.f, 0.f, 0.f, 0.f};
#pragma unroll
  for (int ks = 0; ks < 2; ++ks)
#pragma unroll
    for (int ksub = 0; ksub < 4; ++ksub) {
      bf16x8 kf = *(const bf16x8*)(Ks + (ksub * 16 + fr) * LS + ks * 32 + fq * 8);
#pragma unroll
      for (int g = 0; g < 2; ++g) s[g][ksub] = __builtin_amdgcn_mfma_f32_16x16x32_bf16(kf, qf[g][ks], s[g][ksub], 0, 0, 0);
    }
}

template <bool WITH_L>
DEVI void pv_accum_t(f32x4 (&o)[2][4], f32x4 (&ol)[2], const f32x4 (&pr)[2][4], const bfu* Vt, int fr, int fq) {
#pragma unroll
  for (int kp = 0; kp < 2; ++kp) {
    bf16x8 pf[2];
#pragma unroll
    for (int g = 0; g < 2; ++g) {
      uint4 u;
      u.x = pack2(pr[g][2 * kp][0], pr[g][2 * kp][1]);
      u.y = pack2(pr[g][2 * kp][2], pr[g][2 * kp][3]);
      u.z = pack2(pr[g][2 * kp + 1][0], pr[g][2 * kp + 1][1]);
      u.w = pack2(pr[g][2 * kp + 1][2], pr[g][2 * kp + 1][3]);
      pf[g] = *(bf16x8*)&u;
    }
    if constexpr (WITH_L) {
      const short one = (fr == 0) ? (short)0x3F80 : (short)0;
      const bf16x8 vones = {one, one, one, one, one, one, one, one};
#pragma unroll
      for (int g = 0; g < 2; ++g) ol[g] = __builtin_amdgcn_mfma_f32_16x16x32_bf16(vones, pf[g], ol[g], 0, 0, 0);
    }
#pragma unroll
    for (int dsub = 0; dsub < 4; ++dsub) {
      uint2 lo = *(const uint2*)(Vt + (dsub * 16 + fr) * LS + (2 * kp) * 16 + fq * 4);
      uint2 hi = *(const uint2*)(Vt + (dsub * 16 + fr) * LS + (2 * kp + 1) * 16 + fq * 4);
      uint4 u; u.x = lo.x; u.y = lo.y; u.z = hi.x; u.w = hi.y;
      bf16x8 vf = *(bf16x8*)&u;
#pragma unroll
      for (int g = 0; g < 2; ++g) o[g][dsub] = __builtin_amdgcn_mfma_f32_16x16x32_bf16(vf, pf[g], o[g][dsub], 0, 0, 0);
    }
  }
}

DEVI void pv_accum(f32x4 (&o)[2][4], const f32x4 (&pr)[2][4], const bfu* Vt, int fr, int fq) {
  f32x4 dummy[2];
  pv_accum_t<false>(o, dummy, pr, Vt, fr, fq);
}

struct AttnState {
  f32x4 o[2][4];
  f32x4 ol[2];
  float m[2];
};

DEVI void attn_step(AttnState& st, const bf16x8 (&qf)[2][2], const bfu* Ks, const bfu* Vt, int hi, int lo, int fr, int fq) {
  const int hi4 = hi - fq * 4, lo4 = lo - fq * 4;
  f32x4 s[2][4];
  compute_S(s, qf, Ks, fr, fq);
  const bool anymask = __builtin_amdgcn_ballot_w64((hi < 63) || (lo >= 0)) != 0ull;
  if (anymask) {
#pragma unroll
    for (int g = 0; g < 2; ++g)
#pragma unroll
      for (int ksub = 0; ksub < 4; ++ksub)
#pragma unroll
        for (int j = 0; j < 4; ++j) {
          const int c = ksub * 16 + j;
          const bool v = (c <= hi4) && (c > lo4);
          s[g][ksub][j] = v ? s[g][ksub][j] : NEGF;
        }
  }
  float scs[2];
#pragma unroll
  for (int g = 0; g < 2; ++g) {
    float mx = NEGF;
#pragma unroll
    for (int ksub = 0; ksub < 4; ++ksub)
#pragma unroll
      for (int j = 0; j < 4; ++j) mx = fmaxf(mx, s[g][ksub][j]);
    mx = fmaxf(mx, __shfl_xor(mx, 16));
    mx = fmaxf(mx, __shfl_xor(mx, 32));
    float mn = fmaxf(st.m[g], mx);
    float sc = __builtin_amdgcn_exp2f(st.m[g] - mn);
#pragma unroll
    for (int ksub = 0; ksub < 4; ++ksub)
#pragma unroll
      for (int j = 0; j < 4; ++j) s[g][ksub][j] = __builtin_amdgcn_exp2f(s[g][ksub][j] - mn);
    st.m[g] = mn;
    scs[g] = sc;
  }
  if (__builtin_amdgcn_ballot_w64((scs[0] != 1.f) || (scs[1] != 1.f)) != 0ull) {
#pragma unroll
    for (int g = 0; g < 2; ++g) {
      st.ol[g] *= scs[g];
#pragma unroll
      for (int dsub = 0; dsub < 4; ++dsub) st.o[g][dsub] *= scs[g];
    }
  }
  pv_accum_t<true>(st.o, st.ol, s, Vt, fr, fq);
}

DEVI float attn_rowsum(const AttnState& st, int g) {
  float v = st.ol[g][0];
  v += __shfl_xor(v, 16);
  v += __shfl_xor(v, 32);
  return v;
}

DEVI void attn_init(AttnState& st) {
#pragma unroll
  for (int g = 0; g < 2; ++g) {
    st.m[g] = NEGF; st.ol[g] = f32x4{0.f, 0.f, 0.f, 0.f};
#pragma unroll
    for (int d = 0; d < 4; ++d) st.o[g][d] = f32x4{0.f, 0.f, 0.f, 0.f};
  }
}

DEVI void nsa_item(const Params& p, int l, int item, char* lds_raw, volatile int* nsa_cnt) {
  bfu* Kb = (bfu*)lds_raw;
  bfu* Vb = Kb + 128 * LS;
  float* Gs = (float*)(Vb + 128 * LS);
  float* Ls_ = Gs + 64 * 33;
  float* Pb = Ls_ + 64 * 33;
  unsigned* selm = (unsigned*)(Pb + 64 * 33);
  const int qt = 31 - (item >> 4), bh = item & 15, b = bh >> 1, h = bh & 1;
  const int tid = get_tid(), lane = tid & 63, wid = tid >> 6, fr = lane & 15, fq = lane >> 4;
  const bfu* proj = (const bfu*)(p.ws + OFF_PROJ);
  const long tokbase = (long)b * SEQ;
  const int t0 = qt * 64;
  const int tokl = wid * 16 + fr;
  const int mytok = t0 + tokl;
  const bfu* myrow = proj + (tokbase + mytok) * LDP;
  bf16x8 qf[2][2];
#pragma unroll
  for (int g = 0; g < 2; ++g)
#pragma unroll
    for (int ks = 0; ks < 2; ++ks) qf[g][ks] = *(const bf16x8*)(myrow + C_Q + (h * 2 + g) * 64 + ks * 32 + fq * 8);
  float gate[2][3];
#pragma unroll
  for (int g = 0; g < 2; ++g)
#pragma unroll
    for (int br = 0; br < 3; ++br) gate[g][br] = sigmoidf_(bf2f(myrow[C_NG + (h * 2 + g) * 3 + br]));
  f32x4 fin[2][4];
#pragma unroll
  for (int g = 0; g < 2; ++g)
#pragma unroll
    for (int d = 0; d < 4; ++d) fin[g][d] = f32x4{0.f, 0.f, 0.f, 0.f};

  const int ntile = (t0 + 32 >= 1024) ? 2 : 1;
  __syncthreads();
  {
    const bfu* kc = (const bfu*)(p.ws + OFF_KCMP) + (long)(b * 2 + h) * 128 * 64;
    const bfu* vc = (const bfu*)(p.ws + OFF_VCT) + (long)(b * 2 + h) * 64 * 128;
    for (int i = 0; i < 2 * ntile; ++i) {
      int id = tid + 256 * i;
      int row = id >> 3, ch = id & 7;
      *(uint4*)(Kb + row * LS + ch * 8) = *(const uint4*)(kc + row * 64 + ch * 8);
    }
    for (int i = 0; i < 2 * ntile; ++i) {
      int id = tid + 256 * i;
      int tt = id >> 9, d = (id >> 3) & 63, ch = id & 7;
      *(uint4*)(Vb + tt * 64 * LS + d * LS + ch * 8) = *(const uint4*)(vc + d * 128 + tt * 64 + ch * 8);
    }
  }
  __syncthreads();
  {
    f32x4 s[2][2][4];
    compute_S(s[0], qf, Kb, fr, fq);
    if (ntile == 2) compute_S(s[1], qf, Kb + 64 * LS, fr, fq);
    else {
#pragma unroll
      for (int g = 0; g < 2; ++g)
#pragma unroll
        for (int k = 0; k < 4; ++k) s[1][g][k] = f32x4{0.f, 0.f, 0.f, 0.f};
    }
    float inv[2];
#pragma unroll
    for (int g = 0; g < 2; ++g) {
      float mx = NEGF;
#pragma unroll
      for (int tt = 0; tt < 2; ++tt)
#pragma unroll
        for (int ksub = 0; ksub < 4; ++ksub)
#pragma unroll
          for (int j = 0; j < 4; ++j) {
            int n = tt * 64 + ksub * 16 + fq * 4 + j;
            bool v = (n * 16 + 31 <= mytok);
            float sv = v ? s[tt][g][ksub][j] : NEGF;
            s[tt][g][ksub][j] = sv;
            mx = fmaxf(mx, sv);
          }
      mx = fmaxf(mx, __shfl_xor(mx, 16));
      mx = fmaxf(mx, __shfl_xor(mx, 32));
      float ps = 0.f;
#pragma unroll
      for (int tt = 0; tt < 2; ++tt)
#pragma unroll
        for (int ksub = 0; ksub < 4; ++ksub)
#pragma unroll
          for (int j = 0; j < 4; ++j) {
            float sv = s[tt][g][ksub][j];
            float pv = (sv > -5e29f) ? __builtin_amdgcn_exp2f(sv - mx) : 0.f;
            s[tt][g][ksub][j] = pv;
            ps += pv;
          }
      ps += __shfl_xor(ps, 16);
      ps += __shfl_xor(ps, 32);
      inv[g] = ps > 0.f ? 1.f / ps : 0.f;
    }
#pragma unroll
    for (int tt = 0; tt < 2; ++tt)
#pragma unroll
      for (int ksub = 0; ksub < 4; ++ksub) {
#pragma unroll
        for (int g = 0; g < 2; ++g) s[tt][g][ksub] *= inv[g];
        float G = 0.f;
#pragma unroll
        for (int g = 0; g < 2; ++g) G += s[tt][g][ksub][0] + s[tt][g][ksub][1] + s[tt][g][ksub][2] + s[tt][g][ksub][3];
        float Lv = s[tt][0][ksub][3] + s[tt][1][ksub][3];
        int J = tt * 16 + ksub * 4 + fq;
        Gs[tokl * 33 + J] = G;
        Ls_[tokl * 33 + J] = Lv;
      }
    f32x4 o[2][4];
#pragma unroll
    for (int g = 0; g < 2; ++g)
#pragma unroll
      for (int d = 0; d < 4; ++d) o[g][d] = f32x4{0.f, 0.f, 0.f, 0.f};
    pv_accum(o, s[0], Vb, fr, fq);
    if (ntile == 2) pv_accum(o, s[1], Vb + 64 * LS, fr, fq);
#pragma unroll
    for (int g = 0; g < 2; ++g)
#pragma unroll
      for (int d = 0; d < 4; ++d) fin[g][d] += o[g][d] * gate[g][0];
  }
  __syncthreads();
  if (tid < 64) {
    const int cur = qt;
    unsigned forced = 1u | (1u << cur) | (cur > 0 ? (1u << (cur - 1)) : 0u);
    unsigned sel = forced;
    int cnt = __popc(forced);
    for (int J = 0; J < 32; ++J) {
      float v = Gs[tid * 33 + J];
      if (J > 0) v += Ls_[tid * 33 + J - 1];
      Pb[tid * 33 + J] = v;
    }
    while (cnt < 8) {
      int best = -1;
      float bv = -1.f;
      for (int J = 0; J <= cur; ++J) {
        float v = Pb[tid * 33 + J];
        if (!((sel >> J) & 1u) && v > bv) { bv = v; best = J; }
      }
      if (best < 0) break;
      sel |= 1u << best;
      ++cnt;
    }
    selm[tid] = sel;
    unsigned om = sel;
#pragma unroll
    for (int o = 32; o >= 1; o >>= 1) om |= (unsigned)__shfl_xor((int)om, o);
    if (tid == 0) selm[64] = om;
  }
  __syncthreads();
  const unsigned mysel = selm[tokl];
  const unsigned ormask = selm[64];

  uint4 rk0, rk1, rv0, rv1;
#define KV_LOAD(KB, VB, JJ)                                                           \
  do {                                                                               \
    rk0 = *(const uint4*)((KB) + (long)((JJ) * 64 + (tid >> 3)) * LDP + (tid & 7) * 8);        \
    rk1 = *(const uint4*)((KB) + (long)((JJ) * 64 + 32 + (tid >> 3)) * LDP + (tid & 7) * 8);   \
    rv0 = *(const uint4*)((VB) + (long)(tid >> 3) * SEQ + (JJ) * 64 + (tid & 7) * 8);          \
    rv1 = *(const uint4*)((VB) + (long)(32 + (tid >> 3)) * SEQ + (JJ) * 64 + (tid & 7) * 8);   \
  } while (0)
#define KV_STORE()                                                    \
  do {                                                                \
    *(uint4*)(Kb + (tid >> 3) * LS + (tid & 7) * 8) = rk0;            \
    *(uint4*)(Kb + (32 + (tid >> 3)) * LS + (tid & 7) * 8) = rk1;     \
    *(uint4*)(Vb + (tid >> 3) * LS + (tid & 7) * 8) = rv0;            \
    *(uint4*)(Vb + (32 + (tid >> 3)) * LS + (tid & 7) * 8) = rv1;     \
  } while (0)
  {
    AttnState st;
    attn_init(st);
    const bfu* kbase = proj + tokbase * LDP + C_KS + h * 64;
    const bfu* vbase = (const bfu*)(p.ws + OFF_VST) + ((long)b * 128 + h * 64) * SEQ;
    unsigned rem = ormask & ((2u << qt) - 1u);
    if (tid == 0) nsa_cnt[vhalf()] = __popc(rem);
    __syncthreads();
    const int niter = max(nsa_cnt[0], nsa_cnt[1]);
    int j = __ffs(rem) - 1;
    KV_LOAD(kbase, vbase, j);
    for (int itx = 0; itx < niter; ++itx) {
      const bool active = (rem != 0u);
      if (active) { j = __ffs(rem) - 1; rem &= rem - 1; }
      __syncthreads();
      if (active) KV_STORE();
      __syncthreads();
      if (active) {
        if (rem) {
          int jn = __ffs(rem) - 1;
          KV_LOAD(kbase, vbase, jn);
        }
        const bool insel = (mysel >> j) & 1u;
        const int hi = insel ? ((j == qt) ? tokl : 63) : -1;
        if (__builtin_amdgcn_ballot_w64(insel) != 0ull) attn_step(st, qf, Kb, Vb, hi, -1, fr, fq);
      }
    }
#pragma unroll
    for (int g = 0; g < 2; ++g) {
      const float lsum = attn_rowsum(st, g);
      float sc = (lsum > 0.f ? 1.f / lsum : 0.f) * gate[g][1];
#pragma unroll
      for (int d = 0; d < 4; ++d) fin[g][d] += st.o[g][d] * sc;
    }
  }
  {
    AttnState st;
    attn_init(st);
    const bfu* kbase = proj + tokbase * LDP + C_KW + h * 64;
    const bfu* vbase = (const bfu*)(p.ws + OFF_VWT) + ((long)b * 128 + h * 64) * SEQ;
    int j = qt - 8 < 0 ? 0 : qt - 8;
    KV_LOAD(kbase, vbase, j);
    for (; j <= qt; ++j) {
      __syncthreads();
      KV_STORE();
      __syncthreads();
      if (j < qt) {
        int jn = j + 1;
        KV_LOAD(kbase, vbase, jn);
      }
      attn_step(st, qf, Kb, Vb, (j == qt) ? tokl : 63, (j == qt - 8) ? tokl : -1, fr, fq);
    }
#pragma unroll
    for (int g = 0; g < 2; ++g) {
      const float lsum = attn_rowsum(st, g);
      float sc = (lsum > 0.f ? 1.f / lsum : 0.f) * gate[g][2];
#pragma unroll
      for (int d = 0; d < 4; ++d) fin[g][d] += st.o[g][d] * sc;
    }
  }
  bfu* y = (bfu*)(p.ws + OFF_Y) + (tokbase + mytok) * LDX + 256 + h * 128;
#pragma unroll
  for (int g = 0; g < 2; ++g)
#pragma unroll
    for (int d = 0; d < 4; ++d) store_bf4(y + g * 64 + d * 16 + fq * 4, fin[g][d]);
}

constexpr int P3B_EXTRA = P3_GMLP + P3_CONF + P3_SCONV;
DEVI void pull_extras(const Params& p, int l, char* lds, volatile int* nsa_cnt, int max_pulls) {
  unsigned* q = (unsigned*)(p.ws + OFF_BAR) + 3500 + l;
  for (int n = 0; n < max_pulls; ++n) {
    __syncthreads();
    if (threadIdx.x == 0) nsa_cnt[2] = (int)atomicAdd(q, 2u);
    __syncthreads();
    const int base = nsa_cnt[2];
    if (base >= P3B_EXTRA) break;
    int i = base + vhalf();
    if (i < P3_GMLP) { gmlp_item(p, l, i, lds); continue; }
    i -= P3_GMLP;
    if (i < P3_CONF) { conf_item(p, l, i, lds); continue; }
    i -= P3_CONF;
    sconv_item(p, l, i);
  }
}
DEVI void phase3b(const Params& p, int l, char* lds, volatile int* nsa_cnt) {
  for (int item = vblk(); item < 512; item += vgrid()) nsa_item(p, l, item, lds, nsa_cnt);
  pull_extras(p, l, lds, nsa_cnt, 1 << 30);
}

DEVI void phase4(const Params& p, int l, char* lds, float* p4s) {
  const bfu* xn = (const bfu*)(p.ws + OFF_XN);
  const bfu* y = (const bfu*)(p.ws + OFF_Y);
  const bfu* wg = (const bfu*)(p.ws + OFF_WGATE);
  const bfu* wb = (const bfu*)(p.ws + OFF_WBR);
  bfu* mixed = (bfu*)(p.ws + OFF_MIX);
  const float* bg = p.in[19] + (long)l * 4096;
  const int lane = get_tid512() & 63, wid = get_tid512() >> 6, wm = wid >> 1, wn = wid & 1, fr = lane & 15, fq = lane >> 4;
  GRing rg{0, 2};
  int mt, nt;
  bool have = tile_map(0, 8, mt, nt);
  for (int it = 0; have; ++it) {
    int mt2 = 0, nt2 = 0;
    const bool have2 = tile_map(it + 1, 8, mt2, nt2);
    const int m0 = mt * 256, n0 = nt * 128;
    uint2 mixp[4][4];
    {
      const int t = get_tid512();
      p4s[t] = bg[(t >> 7) * 1024 + n0 + (t & 127)];
      if (t < 256) {
        const float4 q = *(const float4*)((const float*)(p.ws + OFF_SSQA) + (long)(m0 + t) * 4);
        p4s[512 + t] = ssq_rstd((q.x + q.y) + (q.z + q.w));
      }
    }
#pragma unroll 1
    for (int bb = 0; bb < 4; ++bb) {
      f32x4 acc[4][4];
      uint2 gp[4][4];
      const GUnit ug{xn + (long)m0 * LDX, wg + ((long)bb * 1024 + n0) * LDX, LDX, LDX, 16};
      const GUnit up{y + (long)m0 * LDX + bb * 256, wb + ((long)bb * 1024 + n0) * LDBR, LDX, LDBR, 4};
      const int m0n = (bb < 3) ? m0 : mt2 * 256, n0n = (bb < 3) ? n0 : nt2 * 128, bbn = (bb < 3) ? bb + 1 : 0;
      const GUnit un{xn + (long)m0n * LDX, wg + ((long)bbn * 1024 + n0n) * LDX, LDX, LDX, 16};
      zero_acc<4>(acc);
      gemm8s<false>(acc, ug, up, true, it == 0 && bb == 0, rg, (bfu*)lds);
#pragma unroll
      for (int ni = 0; ni < 4; ++ni) {
        const float4 bv = *(const float4*)(p4s + bb * 128 + wn * 64 + ni * 16 + fq * 4);
#pragma unroll
        for (int mi = 0; mi < 4; ++mi) {
          const float rsm = p4s[512 + wm * 64 + mi * 16 + fr];
          gp[ni][mi].x = pack2(sigmoidf_(acc[ni][mi][0] * rsm + bv.x), sigmoidf_(acc[ni][mi][1] * rsm + bv.y));
          gp[ni][mi].y = pack2(sigmoidf_(acc[ni][mi][2] * rsm + bv.z), sigmoidf_(acc[ni][mi][3] * rsm + bv.w));
        }
      }
      zero_acc<4>(acc);
      gemm8s<false>(acc, up, un, (bb < 3) || have2, false, rg, (bfu*)lds);
#pragma unroll
      for (int ni = 0; ni < 4; ++ni)
#pragma unroll
        for (int mi = 0; mi < 4; ++mi) {
          float v0 = lo2f(gp[ni][mi].x) * acc[ni][mi][0];
          float v1 = hi2f(gp[ni][mi].x) * acc[ni][mi][1];
          float v2 = lo2f(gp[ni][mi].y) * acc[ni][mi][2];
          float v3 = hi2f(gp[ni][mi].y) * acc[ni][mi][3];
          if (bb > 0) {
            v0 += lo2f(mixp[ni][mi].x); v1 += hi2f(mixp[ni][mi].x);
            v2 += lo2f(mixp[ni][mi].y); v3 += hi2f(mixp[ni][mi].y);
          }
          mixp[ni][mi].x = pack2(v0, v1);
          mixp[ni][mi].y = pack2(v2, v3);
        }
    }
#pragma unroll
    for (int ni = 0; ni < 4; ++ni)
#pragma unroll
      for (int mi = 0; mi < 4; ++mi) {
        int n = n0 + wn * 64 + ni * 16 + fq * 4;
        int m = m0 + wm * 64 + mi * 16 + fr;
        *(uint2*)(mixed + (long)m * LDX + n) = mixp[ni][mi];
      }
    mt = mt2; nt = nt2; have = have2;
  }
}

DEVI void phase_resid_gemm(const Params& p, const bfu* A, int lda, int nkt, const bfu* wT, int ldb, const float* resid32,
                           float* ssq_out, float* out32, char* lds) {
  const int lane = get_tid512() & 63, wid = get_tid512() >> 6, wm = wid >> 2, wn = wid & 3, fr = lane & 15, fq = lane >> 4;
  bfu* xs = (bfu*)(p.ws + OFF_XN);
  float* part = (float*)(lds + 131072);
  int stg = 0;
  int mt, nt;
  bool have = tile_map(0, 4, mt, nt);
  for (int it = 0; have; ++it) {
    int mt2 = 0, nt2 = 0;
    const bool have2 = tile_map(it + 1, 4, mt2, nt2);
    const int m0 = mt * 256, n0 = nt * 256;
    const GUnit cur{A + (long)m0 * lda, wT + (long)n0 * ldb, lda, ldb, nkt};
    const GUnit nxt{A + (long)mt2 * 256 * lda, wT + (long)nt2 * 256 * ldb, lda, ldb, nkt};
    f32x4 acc[4][8];
    zero_acc8(acc);
    gemm16s(acc, cur, nxt, have2, it == 0, stg, (bfu*)lds);
    const int nt_cur = nt;
    mt = mt2; nt = nt2; have = have2;
#pragma unroll
    for (int mi = 0; mi < 8; ++mi) {
      const int m = m0 + wm * 128 + mi * 16 + fr;
      float ss = 0.f;
#pragma unroll
      for (int ni = 0; ni < 4; ++ni) {
        const int n = n0 + wn * 64 + ni * 16 + fq * 4;
        float4 r;
        if (resid32) r = *(const float4*)(resid32 + (long)m * 1024 + n);
        else { const uint2 u = *(const uint2*)(xs + (long)m * LDX + n); r = make_float4(lo2f(u.x), hi2f(u.x), lo2f(u.y), hi2f(u.y)); }
        float4 o;
        o.x = r.x + acc[ni][mi][0]; o.y = r.y + acc[ni][mi][1]; o.z = r.z + acc[ni][mi][2]; o.w = r.w + acc[ni][mi][3];
        if (out32) *(float4*)(out32 + (long)m * 1024 + n) = o;
        else {
          uint2 ob; ob.x = pack2(o.x, o.y); ob.y = pack2(o.z, o.w);
          *(uint2*)(xs + (long)m * LDX + n) = ob;
          const float q0 = lo2f(ob.x), q1 = hi2f(ob.x), q2 = lo2f(ob.y), q3 = hi2f(ob.y);
          ss += q0 * q0 + q1 * q1 + q2 * q2 + q3 * q3;
        }
      }
      if (!out32) {
        ss += __shfl_xor(ss, 16);
        ss += __shfl_xor(ss, 32);
        if (fq == 0) part[(wm * 128 + mi * 16 + fr) * 4 + wn] = ss;
      }
    }
    if (!out32) {
      RAW_BARRIER();
      if (get_tid512() < 256) {
        const float4 q = *(const float4*)(part + get_tid512() * 4);
        ssq_out[(long)(m0 + get_tid512()) * 4 + nt_cur] = (q.x + q.y) + (q.z + q.w);
      }
      RAW_BARRIER();
    }
  }
}

DEVI void phase7(const Params& p, int l, char* lds) {
  const bfu* hn = (const bfu*)(p.ws + OFF_XN);
  const bfu* wT = (const bfu*)(p.ws + OFF_WM1);
  bfu* hid = (bfu*)(p.ws + OFF_HID);
  const int lane = get_tid512() & 63, wid = get_tid512() >> 6, wm = wid >> 2, wn = wid & 3, fr = lane & 15, fq = lane >> 4;
  int stg = 0;
  int mt, nt;
  bool have = tile_map(0, 16, mt, nt);
  for (int it = 0; have; ++it) {
    int mt2 = 0, nt2 = 0;
    const bool have2 = tile_map(it + 1, 16, mt2, nt2);
    const int m0 = mt * 256, n0 = nt * 256;
    const GUnit cur{hn + (long)m0 * LDX, wT + (long)n0 * LDX, LDX, LDX, 16};
    const GUnit nxt{hn + (long)mt2 * 256 * LDX, wT + (long)nt2 * 256 * LDX, LDX, LDX, 16};
    const float* rsS = stage_rstd((const float*)(p.ws + OFF_SSQB), m0, it, lds);
    f32x4 acc[4][8];
    zero_acc8(acc);
    gemm16s(acc, cur, nxt, have2, it == 0, stg, (bfu*)lds);
    mt = mt2; nt = nt2; have = have2;
    float rs8[8];
#pragma unroll
    for (int mi = 0; mi < 8; ++mi) rs8[mi] = rsS[wm * 128 + mi * 16 + fr];
#pragma unroll
    for (int ni = 0; ni < 4; ++ni)
#pragma unroll
      for (int mi = 0; mi < 8; ++mi) {
        f32x4 v = acc[ni][mi];
#pragma unroll
        for (int j = 0; j < 4; ++j) { float r = fmaxf(v[j] * rs8[mi], 0.f); v[j] = r * r; }
        int n = n0 + wn * 64 + ni * 16 + fq * 4;
        int m = m0 + wm * 128 + mi * 16 + fr;
        store_bf4(hid + (long)m * LDH + n, v);
      }
  }
}

constexpr int PH_PER_LAYER = 8;
constexpr int N_PHASES = 2 * PH_PER_LAYER;

#define XB_TMO      128
#define XB_XCNT(j)  (256  + 64 * (j))
#define XB_XSUB(j)  (1280 + 64 * (j))
#define XB_XGEN(j)  (2304 + 64 * (j))
#define XB_TOP      3328
#define XB_TOPGEN   3392
#define XCD_BAR_WORDS 3456
#define XB_SPIN_CAP (1u << 20)
#define LAS __attribute__((address_space(3)))
DEVI unsigned xb_ld(unsigned* p) { return __hip_atomic_load(p, __ATOMIC_RELAXED, __HIP_MEMORY_SCOPE_AGENT); }
DEVI unsigned xb_add(unsigned* p, unsigned v) { return __hip_atomic_fetch_add(p, v, __ATOMIC_RELAXED, __HIP_MEMORY_SCOPE_AGENT); }
DEVI unsigned xb_xcc_id() { return (unsigned)__builtin_amdgcn_s_getreg((3 << 11) | 20) & 0xFu; }
#define XB_SPIN(cond, bar) do { unsigned _sp = 0; while (cond) { __builtin_amdgcn_s_sleep(1); \
    if ((++_sp & 255u) == 0u) { if (xb_ld(&(bar)[XB_TMO])) break; if (_sp > XB_SPIN_CAP) { atomicAdd(&(bar)[XB_TMO], 1u); break; } } } } while (0)
struct XcdBarrier { unsigned* bar; unsigned x; volatile LAS unsigned* st; };
DEVI XcdBarrier xcd_barrier_post(unsigned* bar, volatile LAS unsigned* st) {
  XcdBarrier b; b.bar = bar; b.x = xb_xcc_id(); b.st = st;
  if (threadIdx.x == 0) (void)xb_add(&bar[XB_XCNT(b.x)], 1u);
  return b;
}
DEVI void xcd_barrier_complete(unsigned* bar, unsigned x, unsigned& nloc, unsigned& nx) {
  const unsigned G = gridDim.x * gridDim.y * gridDim.z;
  unsigned sum, cnt, mine, sp = 0u;
  for (;;) {
    sum = 0u; cnt = 0u; mine = 0u;
#pragma unroll
    for (unsigned j = 0; j < 16; ++j) { const unsigned c = xb_ld(&bar[XB_XCNT(j)]); sum += c; cnt += (c > 0u) ? 1u : 0u; mine = (j == x) ? c : mine; }
    if (sum == G) break;
    __builtin_amdgcn_s_sleep(1);
    if ((++sp & 255u) == 0u) { if (xb_ld(&bar[XB_TMO])) break; if (sp > XB_SPIN_CAP) { atomicAdd(&bar[XB_TMO], 1u); break; } }
  }
  nloc = mine > 0u ? mine : 1u; nx = cnt > 0u ? cnt : 1u;
}
DEVI void xcd_barrier(const XcdBarrier& b) {
  asm volatile("s_waitcnt vmcnt(0)" ::: "memory");
  __syncthreads();
  if (threadIdx.x == 0) {
    unsigned* bar = b.bar;
    __builtin_amdgcn_s_waitcnt(0);
    unsigned nloc = b.st[0], nx = b.st[1];
    if (nloc == 0u) { xcd_barrier_complete(bar, b.x, nloc, nx); b.st[0] = nloc; b.st[1] = nx; }
    const unsigned old = xb_add(&bar[XB_XSUB(b.x)], 1u);
    const unsigned gen = old / nloc;
    if (old + 1u == (gen + 1u) * nloc) {
      __builtin_amdgcn_fence(__ATOMIC_RELEASE, "agent");
      asm volatile("s_waitcnt vmcnt(0)" ::: "memory");
      const unsigned og = xb_add(&bar[XB_TOP], 1u);
      const unsigned tg = og / nx;
      if (og + 1u == (tg + 1u) * nx) xb_add(&bar[XB_TOPGEN], 1u);
      else XB_SPIN(xb_ld(&bar[XB_TOPGEN]) == tg, bar);
      __builtin_amdgcn_fence(__ATOMIC_ACQUIRE, "agent");
      xb_add(&bar[XB_XGEN(b.x)], 1u);
      asm volatile("s_waitcnt vmcnt(0)" ::: "memory");
    } else {
      XB_SPIN(xb_ld(&bar[XB_XGEN(b.x)]) == gen, bar);
      __builtin_amdgcn_fence(__ATOMIC_ACQUIRE, "agent");
      asm volatile("s_waitcnt vmcnt(0)" ::: "memory");
    }
  }
  __syncthreads();
}


DEVI void run_phase(const Params& p, int ph, char* lds, volatile int* nsa_cnt, float* p4s, bool rep) {
  const int l = ph / PH_PER_LAYER, q = ph % PH_PER_LAYER;
  char* hl = lds + vhalf() * LDS_HALF;
  switch (q) {
    case 0: phase1(p, l, hl); break;
    case 1: phase2(p, l, lds); break;
    case 2: phase3a(p, l, hl, rep, nsa_cnt); break;
    case 3: phase3b(p, l, hl, nsa_cnt); break;
    case 4: phase4(p, l, lds, p4s); break;
    case 5: phase_resid_gemm(p, (const bfu*)(p.ws + OFF_MIX), LDX, 16, (const bfu*)(p.ws + OFF_WOUT), LDX,
                             (l == 0) ? p.in[0] : nullptr, (float*)(p.ws + OFF_SSQB), nullptr, lds); break;
    case 6: phase7(p, l, lds); break;
    case 7: phase_resid_gemm(p, (const bfu*)(p.ws + OFF_HID), LDH, 64, (const bfu*)(p.ws + OFF_WM2), LDH, nullptr,
                             (float*)(p.ws + OFF_SSQA), (l == 1) ? p.out : nullptr, lds); break;
  }
}

__global__ void __launch_bounds__(512, 2) fwd_mega(Params p, int ph_lo, int ph_hi, int coop) {
  extern __shared__ __attribute__((aligned(16))) char lds[];
  __shared__ uint4 xb_words;
  __shared__ int nsa_cnt_s[4];
  __shared__ float p4_stage[768];
  XcdBarrier xb;
  if (coop) {
    if (threadIdx.x == 0) xb_words = make_uint4(0u, 0u, 0u, 0u);
    __syncthreads();
    xb = xcd_barrier_post((unsigned*)(p.ws + OFF_BAR), (volatile LAS unsigned*)&xb_words);
  }
  for (int ph = ph_lo; ph < ph_hi; ++ph) {
    run_phase(p, ph, lds, nsa_cnt_s, p4_stage, false);
#ifdef REP_MASK
    if ((REP_MASK >> (ph % PH_PER_LAYER)) & 1) { xcd_barrier(xb); run_phase(p, ph, lds, nsa_cnt_s, p4_stage, true); }
#endif
#ifdef EXTRA_SYNCS
    for (int e = 0; e < EXTRA_SYNCS; ++e) xcd_barrier(xb);
#endif
    if (coop && ph + 1 < ph_hi) {
      if (coop & 2) cg::this_grid().sync();
      else xcd_barrier(xb);
    }
  }
}

extern "C" void kernel_launch(void* const* d_in, const int* in_sizes, int n_in, void* d_out, int out_size, void* d_ws,
                              size_t ws_size, hipStream_t stream) {
  static int grid_blocks = 0;
  if (!grid_blocks) {
    int dev = 0, cus = 0, per_cu = 0;
    hipGetDevice(&dev);
    hipDeviceGetAttribute(&cus, hipDeviceAttributeMultiprocessorCount, dev);
    hipFuncSetAttribute((const void*)fwd_mega, hipFuncAttributeMaxDynamicSharedMemorySize, LDS_BYTES);
    hipOccupancyMaxActiveBlocksPerMultiprocessor(&per_cu, (const void*)fwd_mega, 512, LDS_BYTES);
    if (per_cu < 1) per_cu = 1;
    if (per_cu > 1) per_cu = 1;
    grid_blocks = cus * per_cu;
    if (ws_size < WS_TOTAL) fprintf(stderr, "workspace too small: %zu < %zu\n", ws_size, (size_t)WS_TOTAL);
  }
  Params p{};
  for (int i = 0; i < 24; ++i) p.in[i] = (const float*)d_in[i];
  p.out = (float*)d_out;
  p.ws = (char*)d_ws;
#if MULTI_LAUNCH
  for (int ph = 0; ph < N_PHASES; ++ph) {
    hipLaunchKernelGGL(fwd_mega, dim3(grid_blocks), dim3(512), LDS_BYTES, stream, p, ph, ph + 1, 0);
  }
#else
  hipMemsetAsync((char*)d_ws + OFF_BAR, 0, 16384, stream);
  int lo = 0, hi = N_PHASES, coop = 1;
  void* args[] = {&p, &lo, &hi, &coop};
  hipError_t e = hipLaunchCooperativeKernel((const void*)fwd_mega, dim3(grid_blocks), dim3(512), args, LDS_BYTES, stream);
  if (e != hipSuccess) fprintf(stderr, "cooperative launch failed: %s (grid %d)\n", hipGetErrorString(e), grid_blocks);
#endif
}
```

```cpp
#include <hip/hip_runtime.h>
#include <hip/hip_cooperative_groups.h>
#include <cstdio>
namespace cg = cooperative_groups;

#ifndef MULTI_LAUNCH
#define MULTI_LAUNCH 0
#endif

#define DEVI __device__ __forceinline__
typedef unsigned short bfu;
using bf16x8 = __attribute__((ext_vector_type(8))) short;
using bf16x4 = __attribute__((ext_vector_type(4))) short;
using f32x4  = __attribute__((ext_vector_type(4))) float;

constexpr int NTOK = 16384, SEQ = 2048;
constexpr int LDP = 3072;
constexpr int C_GU = 0, C_GV = 256, C_Q = 512, C_KC = 768, C_VC = 896, C_KS = 1024, C_VS = 1152, C_KW = 1280,
              C_VW = 1408, C_CA = 1536, C_CB = 1792, C_SB = 2048, C_SC = 2304, C_SH = 2560, C_NG = 2816;
constexpr int LDS_HALF = 73728;
constexpr int LDS_BYTES = 2 * LDS_HALF;
constexpr int LDX = 1088;
constexpr int LDH = 4160;
constexpr int LDBR = 320;
constexpr int LS = 72;

constexpr size_t OFF_WIN = 0;
constexpr size_t OFF_WGATE = OFF_WIN + (size_t)LDP * LDX * 2;
constexpr size_t OFF_WBR = OFF_WGATE + (size_t)4096 * LDX * 2;
constexpr size_t OFF_WOUT = OFF_WBR + (size_t)4096 * LDBR * 2;
constexpr size_t OFF_WM1 = OFF_WOUT + (size_t)1024 * LDX * 2;
constexpr size_t OFF_WM2 = OFF_WM1 + (size_t)4096 * LDX * 2;
constexpr size_t OFF_CW1 = OFF_WM2 + (size_t)1024 * LDH * 2;
constexpr size_t OFF_CW2 = OFF_CW1 + 1048576;
constexpr size_t OFF_XN = OFF_CW2 + 32768;
constexpr size_t OFF_PROJ = OFF_XN + (size_t)16384 * LDX * 2;
constexpr size_t OFF_Y = OFF_PROJ + (size_t)16384 * LDP * 2;
constexpr size_t OFF_MIX = OFF_Y + (size_t)16384 * LDX * 2;
constexpr size_t OFF_HID = OFF_PROJ;
constexpr size_t OFF_KCMP = OFF_MIX + (size_t)16384 * LDX * 2;
constexpr size_t OFF_VCT = OFF_KCMP + 262144;
constexpr size_t OFF_VST = OFF_VCT + 262144;
constexpr size_t OFF_VWT = OFF_VST + 4194304;
constexpr size_t OFF_CHID = OFF_VWT + 4194304;
constexpr size_t OFF_PEB = OFF_CHID + 1048576;
constexpr size_t OFF_SSQA = OFF_PEB + 2 * 32 * LDP * 2;
constexpr size_t OFF_SSQB = OFF_SSQA + 16384 * 16;
constexpr size_t OFF_BAR = OFF_SSQB + 16384 * 16;
constexpr size_t WS_TOTAL = OFF_BAR + 16384;
static_assert((size_t)16384 * LDH * 2 <= OFF_KCMP - OFF_PROJ, "hid overlay does not fit");
static_assert(WS_TOTAL <= (size_t)256 * 1024 * 1024, "workspace too large");

struct Params {
  const float* in[24];
  float* out;
  char* ws;
};

DEVI int get_tid() { int t = threadIdx.x & 255; asm volatile("" : "+v"(t)); return t; }
DEVI int get_tid512() { int t = threadIdx.x; asm volatile("" : "+v"(t)); return t; }
DEVI int vhalf() { int t = threadIdx.x >> 8; t = __builtin_amdgcn_readfirstlane(t); return t; }
DEVI int vblk() { return (int)blockIdx.x * 2 + vhalf(); }
DEVI int vgrid() { return (int)gridDim.x * 2; }
DEVI bfu f2bf(float f) {
  unsigned u = __float_as_uint(f);
  u += 0x7fffu + ((u >> 16) & 1u);
  return (bfu)(u >> 16);
}
DEVI float bf2f(bfu h) { return __uint_as_float(((unsigned)h) << 16); }
typedef __bf16 hwbf2 __attribute__((ext_vector_type(2)));
typedef float hwf2 __attribute__((ext_vector_type(2)));
DEVI unsigned pack2(float a, float b) {
  hwf2 v; v.x = a; v.y = b;
  hwbf2 r = __builtin_convertvector(v, hwbf2);
  return *(unsigned*)&r;
}
DEVI float lo2f(unsigned u) { return __uint_as_float(u << 16); }
DEVI float hi2f(unsigned u) { return __uint_as_float(u & 0xffff0000u); }
DEVI float sigmoidf_(float x) { return __builtin_amdgcn_rcpf(1.f + __expf(-x)); }
DEVI float gelu_f(float x) {
  float u = 0.7978845608028654f * (x + 0.044715f * x * x * x);
  return x * __builtin_amdgcn_rcpf(1.f + __expf(-2.f * u));
}
DEVI void store_bf4(bfu* p, f32x4 v) {
  uint2 u; u.x = pack2(v[0], v[1]); u.y = pack2(v[2], v[3]);
  *(uint2*)p = u;
}
DEVI float wave_sum(float v) {
#pragma unroll
  for (int o = 32; o >= 1; o >>= 1) v += __shfl_xor(v, o);
  return v;
}

template <int BN, typename AF>
DEVI void gemm_core(f32x4 (&acc)[BN / 32][4], AF arow, long a_kstride, const bfu* __restrict__ Bt, int ldb, int nkt,
                    bfu* lds) {
  constexpr int NI = BN / 32;
  constexpr int BCH = BN * 8 / 256;
  bfu* As = lds;
  bfu* Bs = lds + 2 * 128 * LS;
  const int tid = get_tid(), lane = tid & 63, wid = tid >> 6, wm = wid >> 1, wn = wid & 1;
  const int fr = lane & 15, fq = lane >> 4;
  const bfu* ap[4];
  const bfu* bp[BCH];
#pragma unroll
  for (int i = 0; i < 4; ++i) { int id = tid + 256 * i; ap[i] = arow(id >> 3) + (id & 7) * 8; }
#pragma unroll
  for (int i = 0; i < BCH; ++i) { int id = tid + 256 * i; bp[i] = Bt + (long)(id >> 3) * ldb + (id & 7) * 8; }
  uint4 ra0_0, ra1_0, ra2_0, ra3_0, rb0_0, rb1_0, rb2_0 = make_uint4(0, 0, 0, 0), rb3_0 = make_uint4(0, 0, 0, 0);
  uint4 ra0_1, ra1_1, ra2_1, ra3_1, rb0_1, rb1_1, rb2_1 = make_uint4(0, 0, 0, 0), rb3_1 = make_uint4(0, 0, 0, 0);
#define G_LOAD(S, KT)                                                     \
  do {                                                                    \
    ra0_##S = *(const uint4*)(ap[0] + (long)(KT) * a_kstride);            \
    ra1_##S = *(const uint4*)(ap[1] + (long)(KT) * a_kstride);            \
    ra2_##S = *(const uint4*)(ap[2] + (long)(KT) * a_kstride);            \
    ra3_##S = *(const uint4*)(ap[3] + (long)(KT) * a_kstride);            \
    rb0_##S = *(const uint4*)(bp[0] + (KT) * 64);                         \
    rb1_##S = *(const uint4*)(bp[1] + (KT) * 64);                         \
    if constexpr (BCH == 4) {                                             \
      rb2_##S = *(const uint4*)(bp[2] + (KT) * 64);                       \
      rb3_##S = *(const uint4*)(bp[3] + (KT) * 64);                       \
    }                                                                     \
  } while (0)
#define L_STORE(S, AW, BW)                                                \
  do {                                                                    \
    *(uint4*)((AW) + ((tid) >> 3) * LS + (tid & 7) * 8) = ra0_##S;        \
    *(uint4*)((AW) + ((tid + 256) >> 3) * LS + (tid & 7) * 8) = ra1_##S;  \
    *(uint4*)((AW) + ((tid + 512) >> 3) * LS + (tid & 7) * 8) = ra2_##S;  \
    *(uint4*)((AW) + ((tid + 768) >> 3) * LS + (tid & 7) * 8) = ra3_##S;  \
    *(uint4*)((BW) + ((tid) >> 3) * LS + (tid & 7) * 8) = rb0_##S;        \
    *(uint4*)((BW) + ((tid + 256) >> 3) * LS + (tid & 7) * 8) = rb1_##S;  \
    if constexpr (BCH == 4) {                                             \
      *(uint4*)((BW) + ((tid + 512) >> 3) * LS + (tid & 7) * 8) = rb2_##S;\
      *(uint4*)((BW) + ((tid + 768) >> 3) * LS + (tid & 7) * 8) = rb3_##S;\
    }                                                                     \
  } while (0)
#define COMPUTE(BUF)                                                                                              \
  do {                                                                                                            \
    const bfu* Ab = As + (BUF) * 128 * LS;                                                                        \
    const bfu* Bb = Bs + (BUF) * BN * LS;                                                                         \
    _Pragma("unroll") for (int ks = 0; ks < 2; ++ks) {                                                            \
      bf16x8 tf[4], wf[NI];                                                                                       \
      _Pragma("unroll") for (int mi = 0; mi < 4; ++mi)                                                            \
        tf[mi] = *(const bf16x8*)(Ab + (wm * 64 + mi * 16 + fr) * LS + ks * 32 + fq * 8);                         \
      _Pragma("unroll") for (int ni = 0; ni < NI; ++ni)                                                           \
        wf[ni] = *(const bf16x8*)(Bb + (wn * (BN / 2) + ni * 16 + fr) * LS + ks * 32 + fq * 8);                   \
      _Pragma("unroll") for (int ni = 0; ni < NI; ++ni)                                                           \
        _Pragma("unroll") for (int mi = 0; mi < 4; ++mi)                                                          \
          acc[ni][mi] = __builtin_amdgcn_mfma_f32_16x16x32_bf16(wf[ni], tf[mi], acc[ni][mi], 0, 0, 0);            \
    }                                                                                                             \
  } while (0)
  G_LOAD(0, 0);
  if (nkt > 1) G_LOAD(1, 1);
  L_STORE(0, As, Bs);
  __syncthreads();
#pragma unroll 1
  for (int kt = 0; kt < nkt; kt += 2) {
    if (kt + 2 < nkt) G_LOAD(0, kt + 2);
    COMPUTE(0);
    if (kt + 1 < nkt) L_STORE(1, As + 128 * LS, Bs + BN * LS);
    __syncthreads();
    if (kt + 1 < nkt) {
      if (kt + 3 < nkt) G_LOAD(1, kt + 3);
      COMPUTE(1);
      if (kt + 2 < nkt) L_STORE(0, As, Bs);
      __syncthreads();
    }
  }
#undef G_LOAD
#undef L_STORE
#undef COMPUTE
}

template <bool PF2>
DEVI void gemm8(f32x4 (&acc)[4][4], const bfu* __restrict__ A, int lda, const bfu* __restrict__ Bt, int ldb, int nkt, bfu* lds) {
  constexpr int LS8 = 64;
  bfu* As = lds;
  bfu* Bs = lds + 2 * 256 * LS8;
  const int tid = get_tid512(), lane = tid & 63, wid = tid >> 6, wm = wid >> 1, wn = wid & 1;
  const int fr = lane & 15, fq = lane >> 4;
  const int wsw = (((tid & 7) ^ ((tid >> 4) & 7)) * 8);
  const int rsw = fr >> 1;
  const char* Ac = (const char*)A;
  const char* Bc = (const char*)Bt;
  const unsigned voffA = (unsigned)(((tid >> 3) * lda + (tid & 7) * 8) * 2);
  const unsigned voffB = (unsigned)(((tid >> 3) * ldb + (tid & 7) * 8) * 2);
  const size_t strA = (size_t)64 * lda * 2, strB = (size_t)64 * ldb * 2;
  uint4 ra0_0, ra1_0, ra2_0, ra3_0, rb0_0, rb1_0;
  uint4 ra0_1 = make_uint4(0, 0, 0, 0), ra1_1 = ra0_1, ra2_1 = ra0_1, ra3_1 = ra0_1, rb0_1 = ra0_1, rb1_1 = ra0_1;
#define G_LOAD(S, KT)                                          \
  do {                                                         \
    ra0_##S = *(const uint4*)(Ac + (size_t)(KT) * 128 + voffA);                 \
    ra1_##S = *(const uint4*)(Ac + strA + (size_t)(KT) * 128 + voffA);          \
    ra2_##S = *(const uint4*)(Ac + 2 * strA + (size_t)(KT) * 128 + voffA);      \
    ra3_##S = *(const uint4*)(Ac + 3 * strA + (size_t)(KT) * 128 + voffA);      \
    rb0_##S = *(const uint4*)(Bc + (size_t)(KT) * 128 + voffB);                 \
    rb1_##S = *(const uint4*)(Bc + strB + (size_t)(KT) * 128 + voffB);          \
  } while (0)
#define L_STORE(S, AW, BW)                                                  \
  do {                                                                      \
    *(uint4*)((AW) + ((tid) >> 3) * LS8 + wsw) = ra0_##S;          \
    *(uint4*)((AW) + ((tid + 512) >> 3) * LS8 + wsw) = ra1_##S;    \
    *(uint4*)((AW) + ((tid + 1024) >> 3) * LS8 + wsw) = ra2_##S;   \
    *(uint4*)((AW) + ((tid + 1536) >> 3) * LS8 + wsw) = ra3_##S;   \
    *(uint4*)((BW) + ((tid) >> 3) * LS8 + wsw) = rb0_##S;          \
    *(uint4*)((BW) + ((tid + 512) >> 3) * LS8 + wsw) = rb1_##S;    \
  } while (0)
#define COMPUTE(BUF)                                                                                              \
  do {                                                                                                            \
    const bfu* Ab = As + (BUF) * 256 * LS8;                                                                       \
    const bfu* Bb = Bs + (BUF) * 128 * LS8;                                                                       \
    _Pragma("unroll") for (int ks = 0; ks < 2; ++ks) {                                                            \
      bf16x8 tf[4];                                                                                               \
      _Pragma("unroll") for (int mi = 0; mi < 4; ++mi)                                                            \
        tf[mi] = *(const bf16x8*)(Ab + (wm * 64 + mi * 16 + fr) * LS8 + (((ks * 4 + fq) ^ rsw) * 8));                         \
      if constexpr (PF2) {                                                                                        \
        bf16x8 wf[4];                                                                                             \
        _Pragma("unroll") for (int ni = 0; ni < 4; ++ni)                                                          \
          wf[ni] = *(const bf16x8*)(Bb + (wn * 64 + ni * 16 + fr) * LS8 + (((ks * 4 + fq) ^ rsw) * 8));                       \
        _Pragma("unroll") for (int ni = 0; ni < 4; ++ni)                                                          \
          _Pragma("unroll") for (int mi = 0; mi < 4; ++mi)                                                        \
            acc[ni][mi] = __builtin_amdgcn_mfma_f32_16x16x32_bf16(wf[ni], tf[mi], acc[ni][mi], 0, 0, 0);          \
      } else {                                                                                                    \
        _Pragma("unroll") for (int ni = 0; ni < 4; ++ni) {                                                        \
          bf16x8 wf1 = *(const bf16x8*)(Bb + (wn * 64 + ni * 16 + fr) * LS8 + (((ks * 4 + fq) ^ rsw) * 8));                   \
          _Pragma("unroll") for (int mi = 0; mi < 4; ++mi)                                                        \
            acc[ni][mi] = __builtin_amdgcn_mfma_f32_16x16x32_bf16(wf1, tf[mi], acc[ni][mi], 0, 0, 0);             \
          __builtin_amdgcn_sched_barrier(0);                                                                      \
        }                                                                                                         \
      }                                                                                                           \
    }                                                                                                             \
  } while (0)
  if constexpr (PF2) {
    G_LOAD(0, 0);
    if (nkt > 1) G_LOAD(1, 1);
    L_STORE(0, As, Bs);
    __syncthreads();
#pragma unroll 1
    for (int kt = 0; kt < nkt; kt += 2) {
      if (kt + 2 < nkt) G_LOAD(0, kt + 2);
      COMPUTE(0);
      if (kt + 1 < nkt) L_STORE(1, As + 256 * LS8, Bs + 128 * LS8);
      __syncthreads();
      if (kt + 1 < nkt) {
        if (kt + 3 < nkt) G_LOAD(1, kt + 3);
        COMPUTE(1);
        if (kt + 2 < nkt) L_STORE(0, As, Bs);
        __syncthreads();
      }
    }
  } else {
    G_LOAD(0, 0);
    L_STORE(0, As, Bs);
    __syncthreads();
#pragma unroll 1
    for (int kt = 0; kt < nkt; ++kt) {
      const int buf = kt & 1;
      const bool more = kt + 1 < nkt;
      if (more) G_LOAD(0, kt + 1);
      COMPUTE(buf);
      if (more) L_STORE(0, As + (buf ^ 1) * 256 * LS8, Bs + (buf ^ 1) * 128 * LS8);
      __syncthreads();
    }
  }
#undef G_LOAD
#undef L_STORE
#undef COMPUTE
}

#define RAW_BARRIER() do { asm volatile("s_waitcnt lgkmcnt(0)" ::: "memory"); __builtin_amdgcn_s_barrier(); } while (0)
DEVI void glds16(const char* g, char* l) {
  __builtin_amdgcn_global_load_lds((const unsigned*)g, (__attribute__((address_space(3))) unsigned*)l, 16, 0, 0);
}
struct GUnit { const bfu* A; const bfu* B; int lda, ldb, nkt; };
struct GRing { int st, st2; };

template <bool WIDE>
DEVI void gemm8s(f32x4 (&acc)[4][4], const GUnit& cur, const GUnit& nxt, bool has_next, bool first, GRing& rg, bfu* lds,
                   bool clean = false) {
  constexpr int STGB = 384 * 128;
  const int tid = get_tid512(), lane = tid & 63, wid = tid >> 6, wm = wid >> 1, wn = wid & 1;
  const int fr = lane & 15, fq = lane >> 4;
  const int rsw = fr >> 1;
  const int lc = (tid & 7) ^ ((tid >> 4) & 7);
  const int rr = tid >> 3;
  const int lc8 = lc * 8;
  char* lbase = (char*)lds + __builtin_amdgcn_readfirstlane(wid) * 1024;
  const int nkt = cur.nkt;
#define ISSUE(AC, BC, SA, SB, VA, VB, KT, ST)                                      \
  do {                                                                             \
    char* sb = lbase + (ST) * STGB;                                                \
    const size_t ko = (size_t)(KT) * 128;                                          \
    glds16((AC) + ko + (VA), sb);                                                  \
    glds16((AC) + (SA) + ko + (VA), sb + 8192);                                    \
    glds16((AC) + 2 * (SA) + ko + (VA), sb + 16384);                               \
    glds16((AC) + 3 * (SA) + ko + (VA), sb + 24576);                               \
    glds16((BC) + ko + (VB), sb + 32768);                                          \
    glds16((BC) + (SB) + ko + (VB), sb + 40960);                                   \
  } while (0)
  const char* Acc = (const char*)cur.A;
  const char* Bcc = (const char*)cur.B;
  const size_t sAc = (size_t)64 * cur.lda * 2, sBc = (size_t)64 * cur.ldb * 2;
  const char* Acn = (const char*)nxt.A;
  const char* Bcn = (const char*)nxt.B;
  const size_t sAn = (size_t)64 * nxt.lda * 2, sBn = (size_t)64 * nxt.ldb * 2;
  if (first) {
    asm volatile("s_waitcnt vmcnt(0)" ::: "memory");
    const unsigned v0A = (unsigned)((rr * cur.lda + lc8) * 2), v0B = (unsigned)((rr * cur.ldb + lc8) * 2);
    ISSUE(Acc, Bcc, sAc, sBc, v0A, v0B, 0, rg.st);
    ISSUE(Acc, Bcc, sAc, sBc, v0A, v0B, 1, (rg.st == 2) ? 0 : rg.st + 1);
  }
  int st = rg.st, st2 = rg.st2;
  const int grp = WIDE ? 0 : __builtin_amdgcn_readfirstlane(wid >> 2);
  if (grp == 0) {
#pragma unroll 1
  for (int kt = 0; kt < nkt; ++kt) {
    if (kt == 0 && !first && !clean) asm volatile("s_waitcnt vmcnt(0)" ::: "memory");
    else asm volatile("s_waitcnt vmcnt(6)" ::: "memory");
    RAW_BARRIER();
    const bool own = (kt + 2 < nkt);
    const bool fromn = !own && has_next;
    const int tk = own ? kt + 2 : (fromn ? kt + 2 - nkt : nkt - 1);
    const char* Ai = fromn ? Acn : Acc;
    const char* Bi = fromn ? Bcn : Bcc;
    const size_t sAi = fromn ? sAn : sAc, sBi = fromn ? sBn : sBc;
    const int ldai_ = fromn ? nxt.lda : cur.lda, ldbi_ = fromn ? nxt.ldb : cur.ldb;
    const unsigned vAi = (unsigned)((rr * ldai_ + lc8) * 2), vBi = (unsigned)((rr * ldbi_ + lc8) * 2);
    const bfu* Ab = (const bfu*)((const char*)lds + st * STGB);
    const bfu* Bb = Ab + 256 * 64;
    bf16x8 tf[2][4], wf[2][4];
#pragma unroll
    for (int ks = 0; ks < 2; ++ks) {
#pragma unroll
      for (int mi = 0; mi < 4; ++mi) tf[ks][mi] = *(const bf16x8*)(Ab + (wm * 64 + mi * 16 + fr) * 64 + (((ks * 4 + fq) ^ rsw) * 8));
#pragma unroll
      for (int ni = 0; ni < 4; ++ni) wf[ks][ni] = *(const bf16x8*)(Bb + (wn * 64 + ni * 16 + fr) * 64 + (((ks * 4 + fq) ^ rsw) * 8));
    }
    ISSUE(Ai, Bi, sAi, sBi, vAi, vBi, tk, st2);
#pragma unroll
    for (int ks = 0; ks < 2; ++ks)
#pragma unroll
      for (int ni = 0; ni < 4; ++ni)
#pragma unroll
        for (int mi = 0; mi < 4; ++mi)
          acc[ni][mi] = __builtin_amdgcn_mfma_f32_16x16x32_bf16(wf[ks][ni], tf[ks][mi], acc[ni][mi], 0, 0, 0);
    if constexpr (WIDE) {
      __builtin_amdgcn_sched_group_barrier(0x100, 8, 0);
#pragma unroll
      for (int i = 0; i < 6; ++i) {
        __builtin_amdgcn_sched_group_barrier(0x008, 2, 0);
        __builtin_amdgcn_sched_group_barrier(0x020, 1, 0);
      }
#pragma unroll
      for (int i = 0; i < 4; ++i) {
        __builtin_amdgcn_sched_group_barrier(0x008, 1, 0);
        __builtin_amdgcn_sched_group_barrier(0x100, 2, 0);
      }
      __builtin_amdgcn_sched_group_barrier(0x008, 16, 0);
    }
    st = (st == 2) ? 0 : st + 1;
    st2 = (st2 == 2) ? 0 : st2 + 1;
  }
  } else {
    bf16x8 ctf[4], cwf[4];
#pragma unroll
    for (int i = 0; i < 4; ++i) { ctf[i] = bf16x8{0, 0, 0, 0, 0, 0, 0, 0}; cwf[i] = bf16x8{0, 0, 0, 0, 0, 0, 0, 0}; }
#pragma unroll 1
  for (int kt = 0; kt < nkt; ++kt) {
    if (kt == 0 && !first && !clean) asm volatile("s_waitcnt vmcnt(0)" ::: "memory");
    else asm volatile("s_waitcnt vmcnt(6)" ::: "memory");
    RAW_BARRIER();
    const bool own = (kt + 2 < nkt);
    const bool fromn = !own && has_next;
    const int tk = own ? kt + 2 : (fromn ? kt + 2 - nkt : nkt - 1);
    const char* Ai = fromn ? Acn : Acc;
    const char* Bi = fromn ? Bcn : Bcc;
    const size_t sAi = fromn ? sAn : sAc, sBi = fromn ? sBn : sBc;
    const int ldai_ = fromn ? nxt.lda : cur.lda, ldbi_ = fromn ? nxt.ldb : cur.ldb;
    const unsigned vAi = (unsigned)((rr * ldai_ + lc8) * 2), vBi = (unsigned)((rr * ldbi_ + lc8) * 2);
    const bfu* Ab = (const bfu*)((const char*)lds + st * STGB);
    const bfu* Bb = Ab + 256 * 64;
    ISSUE(Ai, Bi, sAi, sBi, vAi, vBi, tk, st2);
#pragma unroll
    for (int ni = 0; ni < 4; ++ni)
#pragma unroll
      for (int mi = 0; mi < 4; ++mi)
        acc[ni][mi] = __builtin_amdgcn_mfma_f32_16x16x32_bf16(cwf[ni], ctf[mi], acc[ni][mi], 0, 0, 0);
    __builtin_amdgcn_sched_barrier(0);
    bf16x8 tf0[4], wf0[4];
#pragma unroll
    for (int mi = 0; mi < 4; ++mi) tf0[mi] = *(const bf16x8*)(Ab + (wm * 64 + mi * 16 + fr) * 64 + ((fq ^ rsw) * 8));
#pragma unroll
    for (int ni = 0; ni < 4; ++ni) wf0[ni] = *(const bf16x8*)(Bb + (wn * 64 + ni * 16 + fr) * 64 + ((fq ^ rsw) * 8));
#pragma unroll
    for (int ni = 0; ni < 4; ++ni)
#pragma unroll
      for (int mi = 0; mi < 4; ++mi)
        acc[ni][mi] = __builtin_amdgcn_mfma_f32_16x16x32_bf16(wf0[ni], tf0[mi], acc[ni][mi], 0, 0, 0);
    bf16x8 tf1[4], wf1[4];
#pragma unroll
    for (int mi = 0; mi < 4; ++mi) tf1[mi] = *(const bf16x8*)(Ab + (wm * 64 + mi * 16 + fr) * 64 + (((4 + fq) ^ rsw) * 8));
#pragma unroll
    for (int ni = 0; ni < 4; ++ni) wf1[ni] = *(const bf16x8*)(Bb + (wn * 64 + ni * 16 + fr) * 64 + (((4 + fq) ^ rsw) * 8));
#pragma unroll
    for (int i = 0; i < 4; ++i) { ctf[i] = tf1[i]; cwf[i] = wf1[i]; }
    st = (st == 2) ? 0 : st + 1;
    st2 = (st2 == 2) ? 0 : st2 + 1;
  }
#pragma unroll
    for (int ni = 0; ni < 4; ++ni)
#pragma unroll
      for (int mi = 0; mi < 4; ++mi)
        acc[ni][mi] = __builtin_amdgcn_mfma_f32_16x16x32_bf16(cwf[ni], ctf[mi], acc[ni][mi], 0, 0, 0);
  }
  rg.st = st; rg.st2 = st2;
  if (!has_next) {
    asm volatile("s_waitcnt vmcnt(0)" ::: "memory");
    RAW_BARRIER();
  }
#undef ISSUE
}

DEVI void gemm16s(f32x4 (&acc)[4][8], const GUnit& cur, const GUnit& nxt, bool has_next, bool first, int& stg, bfu* lds) {
  constexpr int STGB = 512 * 128;
  const int tid = get_tid512(), lane = tid & 63, wid = tid >> 6, wm = wid >> 2, wn = wid & 3;
  const int fr = lane & 15, fq = lane >> 4;
  const int rsw = fr >> 1;
  const int lc = (tid & 7) ^ ((tid >> 4) & 7);
  const int rr = tid >> 3;
  const int lc8 = lc * 8;
  char* lbase = (char*)lds + __builtin_amdgcn_readfirstlane(wid) * 1024;
  const int nkt = cur.nkt;
#define ISSUE16(AC, BC, SA, SB, VA, VB, KT, ST)                                    \
  do {                                                                             \
    char* sb = lbase + (ST) * STGB;                                                \
    const size_t ko = (size_t)(KT) * 128;                                          \
    glds16((AC) + ko + (VA), sb);                                                  \
    glds16((AC) + (SA) + ko + (VA), sb + 8192);                                    \
    glds16((AC) + 2 * (SA) + ko + (VA), sb + 16384);                               \
    glds16((AC) + 3 * (SA) + ko + (VA), sb + 24576);                               \
    glds16((BC) + ko + (VB), sb + 32768);                                          \
    glds16((BC) + (SB) + ko + (VB), sb + 40960);                                   \
    glds16((BC) + 2 * (SB) + ko + (VB), sb + 49152);                               \
    glds16((BC) + 3 * (SB) + ko + (VB), sb + 57344);                               \
  } while (0)
  const char* Acc = (const char*)cur.A;
  const char* Bcc = (const char*)cur.B;
  const size_t sAc = (size_t)64 * cur.lda * 2, sBc = (size_t)64 * cur.ldb * 2;
  const char* Acn = (const char*)nxt.A;
  const char* Bcn = (const char*)nxt.B;
  const size_t sAn = (size_t)64 * nxt.lda * 2, sBn = (size_t)64 * nxt.ldb * 2;
  int st = stg;
  if (first) {
    asm volatile("s_waitcnt vmcnt(0)" ::: "memory");
    ISSUE16(Acc, Bcc, sAc, sBc, (unsigned)((rr * cur.lda + lc8) * 2), (unsigned)((rr * cur.ldb + lc8) * 2), 0, st);
  }
#define G16_HEAD()                                                                                         \
    asm volatile("s_waitcnt vmcnt(0)" ::: "memory");     \
    RAW_BARRIER();                                        \
    const bool own = (kt + 1 < nkt);                                                                          \
    const bool fromn = !own && has_next;                                                                      \
    const int tk = own ? kt + 1 : (fromn ? 0 : nkt - 1);        \
    const char* Ai = fromn ? Acn : Acc;                                                                       \
    const char* Bi = fromn ? Bcn : Bcc;                                                                       \
    const size_t sAi = fromn ? sAn : sAc, sBi = fromn ? sBn : sBc;                                            \
    const int ldai_ = fromn ? nxt.lda : cur.lda, ldbi_ = fromn ? nxt.ldb : cur.ldb;                           \
    const unsigned vAi = (unsigned)((rr * ldai_ + lc8) * 2), vBi = (unsigned)((rr * ldbi_ + lc8) * 2);         \
    const bfu* Ab = (const bfu*)((const char*)lds + st * STGB);                                               \
    const bfu* Bb = Ab + 256 * 64;
#define G16_RD(TF, WF, KS)                                                                                                  \
    _Pragma("unroll") for (int mi = 0; mi < 8; ++mi)                                                                         \
      TF[mi] = *(const bf16x8*)(Ab + (wm * 128 + mi * 16 + fr) * 64 + ((((KS) * 4 + fq) ^ rsw) * 8));                        \
    _Pragma("unroll") for (int ni = 0; ni < 4; ++ni)                                                                         \
      WF[ni] = *(const bf16x8*)(Bb + (wn * 64 + ni * 16 + fr) * 64 + ((((KS) * 4 + fq) ^ rsw) * 8));
#define G16_MM(TF, WF)                                                                                        \
    _Pragma("unroll") for (int ni = 0; ni < 4; ++ni)                                                           \
      _Pragma("unroll") for (int mi = 0; mi < 8; ++mi)                                                         \
        acc[ni][mi] = __builtin_amdgcn_mfma_f32_16x16x32_bf16(WF[ni], TF[mi], acc[ni][mi], 0, 0, 0);
  const int grp = __builtin_amdgcn_readfirstlane(wid >> 2);
  if (grp == 0) {
#pragma unroll 1
    for (int kt = 0; kt < nkt; ++kt) {
      G16_HEAD()
      bf16x8 tf0[8], wf0[4];
      G16_RD(tf0, wf0, 0)
      ISSUE16(Ai, Bi, sAi, sBi, vAi, vBi, tk, st ^ 1);
      G16_MM(tf0, wf0)
      bf16x8 tf1[8], wf1[4];
      G16_RD(tf1, wf1, 1)
      G16_MM(tf1, wf1)
      __builtin_amdgcn_sched_group_barrier(0x100, 12, 0);
#pragma unroll
      for (int i = 0; i < 8; ++i) {
        __builtin_amdgcn_sched_group_barrier(0x008, 2, 0);
        __builtin_amdgcn_sched_group_barrier(0x020, 1, 0);
      }
#pragma unroll
      for (int i = 0; i < 12; ++i) {
        __builtin_amdgcn_sched_group_barrier(0x008, 1, 0);
        __builtin_amdgcn_sched_group_barrier(0x100, 1, 0);
      }
      __builtin_amdgcn_sched_group_barrier(0x008, 36, 0);
      st ^= 1;
    }
  } else {
    bf16x8 ctf[8], cwf[4];
#pragma unroll
    for (int mi = 0; mi < 8; ++mi) ctf[mi] = bf16x8{0, 0, 0, 0, 0, 0, 0, 0};
#pragma unroll
    for (int ni = 0; ni < 4; ++ni) cwf[ni] = bf16x8{0, 0, 0, 0, 0, 0, 0, 0};
#pragma unroll 1
    for (int kt = 0; kt < nkt; ++kt) {
      G16_HEAD()
      ISSUE16(Ai, Bi, sAi, sBi, vAi, vBi, tk, st ^ 1);
      G16_MM(ctf, cwf)
      bf16x8 tf0[8], wf0[4];
      G16_RD(tf0, wf0, 0)
      G16_MM(tf0, wf0)
      bf16x8 tf1[8], wf1[4];
      G16_RD(tf1, wf1, 1)
#pragma unroll
      for (int mi = 0; mi < 8; ++mi) ctf[mi] = tf1[mi];
#pragma unroll
      for (int ni = 0; ni < 4; ++ni) cwf[ni] = wf1[ni];
#pragma unroll
      for (int i = 0; i < 8; ++i) {
        __builtin_amdgcn_sched_group_barrier(0x008, 4, 0);
        __builtin_amdgcn_sched_group_barrier(0x020, 1, 0);
      }
      __builtin_amdgcn_sched_group_barrier(0x100, 12, 0);
#pragma unroll
      for (int i = 0; i < 12; ++i) {
        __builtin_amdgcn_sched_group_barrier(0x008, 2, 0);
        __builtin_amdgcn_sched_group_barrier(0x100, 1, 0);
      }
      __builtin_amdgcn_sched_group_barrier(0x008, 8, 0);
      st ^= 1;
    }
    G16_MM(ctf, cwf)
  }
#undef G16_HEAD
#undef G16_RD
#undef G16_MM
  stg = st;
  if (!has_next) {
    asm volatile("s_waitcnt vmcnt(0)" ::: "memory");
    RAW_BARRIER();
  }
#undef ISSUE16
}

DEVI void zero_acc8(f32x4 (&acc)[4][8]) {
#pragma unroll
  for (int a = 0; a < 4; ++a)
#pragma unroll
    for (int b = 0; b < 8; ++b) acc[a][b] = f32x4{0.f, 0.f, 0.f, 0.f};
}

DEVI bool tile_map(int it, int NT, int& mt, int& nt) {
  const int x = blockIdx.x & 7, j = blockIdx.x >> 3, nxb = gridDim.x >> 3;
  const int q = it * nxb + j;
  if (q >= 8 * NT) return false;
  const int band = q / (4 * NT), r = q - band * 4 * NT;
  nt = r >> 2;
  mt = x * 8 + band * 4 + (r & 3);
  return true;
}

template <int NI>
DEVI void zero_acc(f32x4 (&acc)[NI][4]) {
#pragma unroll
  for (int a = 0; a < NI; ++a)
#pragma unroll
    for (int b = 0; b < 4; ++b) acc[a][b] = f32x4{0.f, 0.f, 0.f, 0.f};
}

DEVI void cvt_tile(const float* __restrict__ src, int ld_src, int col0, int valid, bfu* __restrict__ dst, int ld_dst,
                   char* lds_raw, const float* __restrict__ gain = nullptr) {
  float* tile = (float*)lds_raw;
  const int tid = get_tid();
  __syncthreads();
#pragma unroll
  for (int i = 0; i < 4; ++i) {
    int id = tid + 256 * i;
    int row = id >> 4, c4 = id & 15;
    float4 v = make_float4(0.f, 0.f, 0.f, 0.f);
    if (c4 * 4 < valid) {
      const f32x4 w = __builtin_nontemporal_load((const f32x4*)(src + (long)row * ld_src + col0 + c4 * 4));
      v = make_float4(w[0], w[1], w[2], w[3]);
    }
    if (gain) { const float gk = gain[row]; v.x *= gk; v.y *= gk; v.z *= gk; v.w *= gk; }
    float* t = tile + row * 65 + c4 * 4;
    t[0] = v.x; t[1] = v.y; t[2] = v.z; t[3] = v.w;
  }
  __syncthreads();
#pragma unroll
  for (int i = 0; i < 2; ++i) {
    int id = tid + 256 * i;
    int n = id >> 3, kc = id & 7;
    uint4 o;
    o.x = pack2(tile[(kc * 8 + 0) * 65 + n], tile[(kc * 8 + 1) * 65 + n]);
    o.y = pack2(tile[(kc * 8 + 2) * 65 + n], tile[(kc * 8 + 3) * 65 + n]);
    o.z = pack2(tile[(kc * 8 + 4) * 65 + n], tile[(kc * 8 + 5) * 65 + n]);
    o.w = pack2(tile[(kc * 8 + 6) * 65 + n], tile[(kc * 8 + 7) * 65 + n]);
    *(uint4*)(dst + (long)n * ld_dst + kc * 8) = o;
  }
}

constexpr int P1_CVT = 4484;
constexpr int P1_BIAS = 2;
constexpr int P1_RMS = 1024;
constexpr int P1_ITEMS = P1_CVT + P1_BIAS + P1_RMS;

DEVI void rms_rows(const float* __restrict__ x, float* __restrict__ ssq, bfu* __restrict__ dst, int item) {
  const int lane = get_tid() & 63, wid = get_tid() >> 6;
  float4 v[4][4];
#pragma unroll
  for (int r = 0; r < 4; ++r) {
    const float4* xr = (const float4*)(x + ((long)item * 16 + wid * 4 + r) * 1024);
#pragma unroll
    for (int i = 0; i < 4; ++i) v[r][i] = xr[lane + 64 * i];
  }
#pragma unroll
  for (int r = 0; r < 4; ++r) {
    long row = (long)item * 16 + wid * 4 + r;
    float ss = 0.f;
#pragma unroll
    for (int i = 0; i < 4; ++i) ss += v[r][i].x * v[r][i].x + v[r][i].y * v[r][i].y + v[r][i].z * v[r][i].z + v[r][i].w * v[r][i].w;
    ss = wave_sum(ss);
    if (lane == 0) *(float4*)(ssq + row * 4) = make_float4(ss, 0.f, 0.f, 0.f);
#pragma unroll
    for (int i = 0; i < 4; ++i) {
      uint2 o;
      o.x = pack2(v[r][i].x, v[r][i].y);
      o.y = pack2(v[r][i].z, v[r][i].w);
      *(uint2*)(dst + row * LDX + (lane + 64 * i) * 4) = o;
    }
  }
}
DEVI float row_ssq(const float* __restrict__ ssq, long m) {
  const float4 q = *(const float4*)(ssq + m * 4);
  float v = (q.x + q.y) + (q.z + q.w);
  asm volatile("" : "+v"(v));
  return v;
}
DEVI float ssq_rstd(float v) { return rsqrtf(v * (1.f / 1024.f) + 1e-6f); }
DEVI float* stage_rstd(const float* __restrict__ ssq, int m0, int it, char* lds) {
  float* rsS = (float*)(lds + 131072 + 8192) + (it & 1) * 256;
  const int t = get_tid512();
  if (t < 256) {
    const float4 q = *(const float4*)(ssq + (long)(m0 + t) * 4);
    rsS[t] = ssq_rstd((q.x + q.y) + (q.z + q.w));
  }
  return rsS;
}

DEVI void phase1(const Params& p, int l, char* lds) {
  char* ws = p.ws;
  const float* xin = (l == 0) ? p.in[0] : p.out;
  const int n_items = P1_CVT + P1_BIAS + (l == 0 ? P1_RMS : 0);
  for (int item = vblk(); item < n_items; item += vgrid()) {
    int i = item;
    if (i < P1_CVT) {
      if (i < 768) {
        int kt = i / 48, nt = i % 48;
        int col0, valid;
        if (nt < 24) { col0 = nt * 64; valid = 64; }
        else if (nt < 44) { col0 = nt * 64 + 12; valid = 64; }
        else if (nt == 44) { col0 = 1536; valid = 12; }
        else { col0 = 0; valid = 0; }
        cvt_tile(p.in[2] + (long)l * 1024 * 2828 + (long)kt * 64 * 2828, 2828, col0, valid,
                 (bfu*)(ws + OFF_WIN) + (long)nt * 64 * LDX + kt * 64, LDX, lds, p.in[1] + l * 1024 + kt * 64);
        continue;
      }
      i -= 768;
      if (i < 1024) {
        int kt = i / 64, nt = i % 64;
        cvt_tile(p.in[18] + (long)l * 1024 * 4096 + (long)kt * 64 * 4096, 4096, nt * 64, 64,
                 (bfu*)(ws + OFF_WGATE) + (long)nt * 64 * LDX + kt * 64, LDX, lds, p.in[1] + l * 1024 + kt * 64);
        continue;
      }
      i -= 1024;
      if (i < 256) {
        int bb = i / 64, r = i % 64, kt = r / 16, nt = r % 16;
        cvt_tile(p.in[17] + ((long)(l * 4 + bb) * 256 + kt * 64) * 1024, 1024, nt * 64, 64,
                 (bfu*)(ws + OFF_WBR) + ((long)bb * 1024 + nt * 64) * LDBR + kt * 64, LDBR, lds);
        continue;
      }
      i -= 256;
      if (i < 256) {
        int kt = i / 16, nt = i % 16;
        cvt_tile(p.in[20] + (long)l * 1024 * 1024 + (long)kt * 64 * 1024, 1024, nt * 64, 64,
                 (bfu*)(ws + OFF_WOUT) + (long)nt * 64 * LDX + kt * 64, LDX, lds);
        continue;
      }
      i -= 256;
      if (i < 1024) {
        int kt = i / 64, nt = i % 64;
        cvt_tile(p.in[22] + (long)l * 1024 * 4096 + (long)kt * 64 * 4096, 4096, nt * 64, 64,
                 (bfu*)(ws + OFF_WM1) + (long)nt * 64 * LDX + kt * 64, LDX, lds, p.in[21] + l * 1024 + kt * 64);
        continue;
      }
      i -= 1024;
      if (i < 1024) {
        int kt = i / 16, nt = i % 16;
        cvt_tile(p.in[23] + (long)l * 4096 * 1024 + (long)kt * 64 * 1024, 1024, nt * 64, 64,
                 (bfu*)(ws + OFF_WM2) + (long)nt * 64 * LDH + kt * 64, LDH, lds);
        continue;
      }
      i -= 1024;
      if (i < 128) {
        int kv = i / 64, r = i % 64, kt = r / 2, nt = r % 2;
        cvt_tile(p.in[10] + ((long)(l * 2 + kv) * 2048 + kt * 64) * 128, 128, nt * 64, 64,
                 (bfu*)(ws + OFF_CW1) + ((long)kv * 128 + nt * 64) * 2048 + kt * 64, 2048, lds);
        continue;
      }
      i -= 128;
      {
        int kv = i / 2, kt = i % 2;
        cvt_tile(p.in[11] + ((long)(l * 2 + kv) * 128 + kt * 64) * 64, 64, 0, 64,
                 (bfu*)(ws + OFF_CW2) + ((long)kv * 64) * 128 + kt * 64, 128, lds);
        continue;
      }
    }
    i -= P1_CVT;
    if (i < P1_BIAS) {
      int kv = i;
      const float* pe = p.in[9] + (long)(l * 2 + kv) * 2048;
      bfu* dst = (bfu*)(ws + OFF_PEB) + (long)kv * 32 * LDP;
      for (int f = get_tid(); f < 2048; f += 256) dst[(f >> 6) * LDP + (f & 63)] = f2bf(pe[f]);
      continue;
    }
    i -= P1_BIAS;
    rms_rows(xin, (float*)(ws + OFF_SSQA), (bfu*)(ws + OFF_XN), i);
  }
}

DEVI void phase2(const Params& p, int l, char* lds) {
  const bfu* xn = (const bfu*)(p.ws + OFF_XN);
  const bfu* wT = (const bfu*)(p.ws + OFF_WIN);
  bfu* proj = (bfu*)(p.ws + OFF_PROJ);
  const int lane = get_tid512() & 63, wid = get_tid512() >> 6, wm = wid >> 2, wn = wid & 3, fr = lane & 15, fq = lane >> 4;
  int stg = 0;
  int mt, nt;
  bool have = tile_map(0, 12, mt, nt);
  for (int it = 0; have; ++it) {
    int mt2 = 0, nt2 = 0;
    const bool have2 = tile_map(it + 1, 12, mt2, nt2);
    const int m0 = mt * 256, n0 = nt * 256;
    const GUnit cur{xn + (long)m0 * LDX, wT + (long)n0 * LDX, LDX, LDX, 16};
    const GUnit nxt{xn + (long)mt2 * 256 * LDX, wT + (long)nt2 * 256 * LDX, LDX, LDX, 16};
    const float* rsS = stage_rstd((const float*)(p.ws + OFF_SSQA), m0, it, lds);
    f32x4 acc[4][8];
    zero_acc8(acc);
    gemm16s(acc, cur, nxt, have2, it == 0, stg, (bfu*)lds);
    const int nt_cur = nt;
    mt = mt2; nt = nt2; have = have2;
#pragma unroll
    for (int mi = 0; mi < 8; ++mi) {
      const float rs = rsS[wm * 128 + mi * 16 + fr];
#pragma unroll
      for (int ni = 0; ni < 4; ++ni) acc[ni][mi] *= rs;
    }
    const bool do_gelu = (n0 < 512);
    const int kind = (nt_cur == 2) ? 1 : ((nt_cur == 4 && wn < 2) ? 2 : ((nt_cur == 5 && wn < 2) ? 3 : 0));
    if (kind) {
      const float* gain = (kind == 1) ? (p.in[7] + l * 64) : (p.in[8] + (l * 3 + (kind == 2 ? 1 : 2)) * 64);
      const float mul = (kind == 1) ? 0.125f * 1.4426950408889634f : 1.f;
#pragma unroll
      for (int mi = 0; mi < 8; ++mi) {
        float ss = 0.f;
#pragma unroll
        for (int ni = 0; ni < 4; ++ni)
#pragma unroll
          for (int j = 0; j < 4; ++j) ss += acc[ni][mi][j] * acc[ni][mi][j];
        ss += __shfl_xor(ss, 16);
        ss += __shfl_xor(ss, 32);
        const float rstd = rsqrtf(ss * (1.f / 64.f) + 1e-6f) * mul;
#pragma unroll
        for (int ni = 0; ni < 4; ++ni) {
          float4 gg = *(const float4*)(gain + ni * 16 + fq * 4);
          acc[ni][mi][0] *= rstd * gg.x; acc[ni][mi][1] *= rstd * gg.y; acc[ni][mi][2] *= rstd * gg.z; acc[ni][mi][3] *= rstd * gg.w;
        }
      }
    }
#pragma unroll
    for (int ni = 0; ni < 4; ++ni)
#pragma unroll
      for (int mi = 0; mi < 8; ++mi) {
        f32x4 v = acc[ni][mi];
        if (do_gelu) { v[0] = gelu_f(v[0]); v[1] = gelu_f(v[1]); v[2] = gelu_f(v[2]); v[3] = gelu_f(v[3]); }
        int n = n0 + wn * 64 + ni * 16 + fq * 4;
        int m = m0 + wm * 128 + mi * 16 + fr;
        store_bf4(proj + (long)m * LDP + n, v);
      }
  }
}

DEVI void compress_item(const Params& p, int l, int ci, char* lds) {
  const int hf = vhalf();
  const bool writer = (hf == 0);
  const bfu* proj = (const bfu*)(p.ws + OFF_PROJ);
  const int kv = ci >> 4, bh = ci & 15, b = bh >> 1, h = bh & 1;
  const int lane = get_tid() & 63, wid = get_tid() >> 6, wm = wid >> 1, wn = wid & 1, fr = lane & 15, fq = lane >> 4;
  bfu* chid = (bfu*)(p.ws + OFF_CHID) + (long)ci * 128 * 128;
  {
    f32x4 acc[4][4];
    zero_acc<4>(acc);
    const bfu* abase = proj + (long)(b * SEQ) * LDP + (kv ? C_VC : C_KC) + h * 64;
    const bfu* peb = (const bfu*)(p.ws + OFF_PEB) + (long)kv * 32 * LDP;
    const long k0 = (long)hf * 16;
    gemm_core<128>(acc, [&](int r) { return (r < 127 ? abase + (long)(r * 16) * LDP : peb) + k0 * LDP; }, (long)LDP,
                   (const bfu*)(p.ws + OFF_CW1) + (long)kv * 128 * 2048 + k0 * 64, 2048, 16, (bfu*)lds);
    {
      float* xch = (float*)(lds + (hf == 0 ? LDS_HALF : 0));
      if (hf == 1) {
#pragma unroll
        for (int ni = 0; ni < 4; ++ni)
#pragma unroll
          for (int mi = 0; mi < 4; ++mi)
#pragma unroll
            for (int j = 0; j < 4; ++j) xch[((ni * 4 + mi) * 4 + j) * 256 + get_tid()] = acc[ni][mi][j];
      }
      __syncthreads();
      if (hf == 0) {
#pragma unroll
        for (int ni = 0; ni < 4; ++ni)
#pragma unroll
          for (int mi = 0; mi < 4; ++mi)
#pragma unroll
            for (int j = 0; j < 4; ++j) acc[ni][mi][j] += xch[((ni * 4 + mi) * 4 + j) * 256 + get_tid()];
      }
      __syncthreads();
    }
    float* biasS = (float*)lds;
    if (wm == 1 && fr == 15) {
#pragma unroll
      for (int ni = 0; ni < 4; ++ni)
#pragma unroll
        for (int j = 0; j < 4; ++j) biasS[wn * 64 + ni * 16 + fq * 4 + j] = acc[ni][3][j];
    }
    __syncthreads();
#pragma unroll
    for (int ni = 0; ni < 4; ++ni)
#pragma unroll
      for (int mi = 0; mi < 4; ++mi) {
        int e = wn * 64 + ni * 16 + fq * 4;
        int m = wm * 64 + mi * 16 + fr;
        f32x4 v = acc[ni][mi];
        float4 bb = *(const float4*)(biasS + e);
        if (m == 127) bb = make_float4(0.f, 0.f, 0.f, 0.f);
        v[0] = gelu_f(v[0] + bb.x); v[1] = gelu_f(v[1] + bb.y); v[2] = gelu_f(v[2] + bb.z); v[3] = gelu_f(v[3] + bb.w);
        if (writer) store_bf4(chid + m * 128 + e, v);
      }
  }
  __threadfence();
  __syncthreads();
  float* outs = (float*)lds;
  {
    f32x4 acc2[2][4];
    zero_acc<2>(acc2);
    gemm_core<64>(acc2, [&](int r) { return (const bfu*)chid + r * 128; }, 64,
                  (const bfu*)(p.ws + OFF_CW2) + (long)kv * 64 * 128, 128, 2, (bfu*)lds);
#pragma unroll
    for (int ni = 0; ni < 2; ++ni)
#pragma unroll
      for (int mi = 0; mi < 4; ++mi) {
        int d = wn * 32 + ni * 16 + fq * 4;
        int m = wm * 64 + mi * 16 + fr;
#pragma unroll
        for (int j = 0; j < 4; ++j) outs[m * 65 + d + j] = acc2[ni][mi][j];
      }
  }
  __syncthreads();
  if (kv == 0) {
    if (writer && get_tid() < 128) {
      int n = get_tid();
      float ss = 0.f;
      for (int d = 0; d < 64; ++d) { float v = outs[n * 65 + d]; ss += v * v; }
      float rstd = rsqrtf(ss * (1.f / 64.f) + 1e-6f);
      const float* kg = p.in[8] + (long)(l * 3 + 0) * 64;
      bfu* dst = (bfu*)(p.ws + OFF_KCMP) + ((long)(b * 2 + h) * 128 + n) * 64;
      for (int d = 0; d < 64; d += 2)
        *(unsigned*)(dst + d) = pack2(outs[n * 65 + d] * rstd * kg[d], outs[n * 65 + d + 1] * rstd * kg[d + 1]);
    }
  } else {
    bfu* dst = (bfu*)(p.ws + OFF_VCT) + (long)(b * 2 + h) * 64 * 128;
    for (int id = get_tid(); writer && id < 64 * 128; id += 256) {
      int d = id >> 7, n = id & 127;
      dst[d * 128 + n] = f2bf(outs[n * 65 + d]);
    }
  }
  __syncthreads();
}

DEVI void gmlp_item(const Params& p, int l, int idx, char* lds) {
  const bfu* proj = (const bfu*)(p.ws + OFF_PROJ);
  bfu* y = (bfu*)(p.ws + OFF_Y);
  const int g = idx & 3, chunk = (idx >> 2) & 15, b = idx >> 6;
  const long tok0 = (long)b * SEQ + chunk * 128;
  const int tid = get_tid(), lane = tid & 63, wid = tid >> 6, fr = lane & 15, fq = lane >> 4;
  constexpr int GS = 136;
  bfu* vlnT = (bfu*)lds;
  bfu* wsm = vlnT + 64 * GS;
  float* stats = (float*)(wsm + 128 * GS);
  __syncthreads();
  {
    const int t = tid >> 1, h2 = tid & 1;
    const uint4* src = (const uint4*)(proj + (tok0 + t) * LDP + C_GV + h2 * 128);
    uint4 u[16];
#pragma unroll
    for (int i = 0; i < 16; ++i) u[i] = src[i];
    float sm = 0.f;
#pragma unroll
    for (int i = 0; i < 16; ++i)
      sm += lo2f(u[i].x) + hi2f(u[i].x) + lo2f(u[i].y) + hi2f(u[i].y) + lo2f(u[i].z) + hi2f(u[i].z) + lo2f(u[i].w) + hi2f(u[i].w);
    sm += __shfl_xor(sm, 1);
    const float mean = sm * (1.f / 256.f);
    float q = 0.f;
#pragma unroll
    for (int i = 0; i < 16; ++i) {
      float d;
      d = lo2f(u[i].x) - mean; q += d * d; d = hi2f(u[i].x) - mean; q += d * d;
      d = lo2f(u[i].y) - mean; q += d * d; d = hi2f(u[i].y) - mean; q += d * d;
      d = lo2f(u[i].z) - mean; q += d * d; d = hi2f(u[i].z) - mean; q += d * d;
      d = lo2f(u[i].w) - mean; q += d * d; d = hi2f(u[i].w) - mean; q += d * d;
    }
    q += __shfl_xor(q, 1);
    if (h2 == 0) { stats[t * 2] = mean; stats[t * 2 + 1] = rsqrtf(q * (1.f / 256.f) + 1e-5f); }
  }
  const float* wsg = p.in[5] + (long)(l * 4 + g) * 128 * 128;
#pragma unroll
  for (int i = 0; i < 16; ++i) {
    int id = tid + 256 * i;
    int t = id >> 5, s4 = (id & 31) * 4;
    float4 w = *(const float4*)(wsg + t * 128 + s4);
    if (s4 + 0 > t) w.x = 0.f;
    if (s4 + 1 > t) w.y = 0.f;
    if (s4 + 2 > t) w.z = 0.f;
    if (s4 + 3 > t) w.w = 0.f;
    uint2 o; o.x = pack2(w.x, w.y); o.y = pack2(w.z, w.w);
    *(uint2*)(wsm + t * GS + s4) = o;
  }
  __syncthreads();
  const float* lg = p.in[3] + l * 256 + g * 64;
  const float* lb = p.in[4] + l * 256 + g * 64;
#pragma unroll
  for (int i = 0; i < 8; ++i) {
    int id = tid + 256 * i;
    int t = id & 127, c4 = (id >> 7) * 4;
    uint2 u = *(const uint2*)(proj + (tok0 + t) * LDP + C_GV + g * 64 + c4);
    float mean = stats[t * 2], rstd = stats[t * 2 + 1];
    float4 gg = *(const float4*)(lg + c4), bb = *(const float4*)(lb + c4);
    vlnT[(c4 + 0) * GS + t] = f2bf((lo2f(u.x) - mean) * rstd * gg.x + bb.x);
    vlnT[(c4 + 1) * GS + t] = f2bf((hi2f(u.x) - mean) * rstd * gg.y + bb.y);
    vlnT[(c4 + 2) * GS + t] = f2bf((lo2f(u.y) - mean) * rstd * gg.z + bb.z);
    vlnT[(c4 + 3) * GS + t] = f2bf((hi2f(u.y) - mean) * rstd * gg.w + bb.w);
  }
  __syncthreads();
  f32x4 acc[4][2];
#pragma unroll
  for (int a = 0; a < 4; ++a)
#pragma unroll
    for (int c = 0; c < 2; ++c) acc[a][c] = f32x4{0.f, 0.f, 0.f, 0.f};
  const int nks = (wid * 32 + 31) / 32 + 1;
  for (int ks = 0; ks < nks; ++ks) {
    bf16x8 af[4], tf[2];
#pragma unroll
    for (int cs = 0; cs < 4; ++cs) af[cs] = *(const bf16x8*)(vlnT + (cs * 16 + fr) * GS + ks * 32 + fq * 8);
#pragma unroll
    for (int ts = 0; ts < 2; ++ts) tf[ts] = *(const bf16x8*)(wsm + ((wid * 2 + ts) * 16 + fr) * GS + ks * 32 + fq * 8);
#pragma unroll
    for (int cs = 0; cs < 4; ++cs)
#pragma unroll
      for (int ts = 0; ts < 2; ++ts) acc[cs][ts] = __builtin_amdgcn_mfma_f32_16x16x32_bf16(af[cs], tf[ts], acc[cs][ts], 0, 0, 0);
  }
  const float* bsg = p.in[6] + (long)(l * 4 + g) * 128;
#pragma unroll
  for (int ts = 0; ts < 2; ++ts) {
    int t = (wid * 2 + ts) * 16 + fr;
    float bsv = bsg[t];
#pragma unroll
    for (int cs = 0; cs < 4; ++cs) {
      int c = cs * 16 + fq * 4;
      uint2 u = *(const uint2*)(proj + (tok0 + t) * LDP + C_GU + g * 64 + c);
      f32x4 v;
      v[0] = lo2f(u.x) * (acc[cs][ts][0] + bsv);
      v[1] = hi2f(u.x) * (acc[cs][ts][1] + bsv);
      v[2] = lo2f(u.y) * (acc[cs][ts][2] + bsv);
      v[3] = hi2f(u.y) * (acc[cs][ts][3] + bsv);
      store_bf4(y + (tok0 + t) * LDX + g * 64 + c, v);
    }
  }
}

DEVI void conf_item(const Params& p, int l, int idx, char* lds) {
  const bfu* proj = (const bfu*)(p.ws + OFF_PROJ);
  bfu* y = (bfu*)(p.ws + OFF_Y);
  const int b = idx >> 6, tile = idx & 63;
  const int t0 = tile * 32;
  const int tid = get_tid(), lane = tid & 63, wid = tid >> 6;
  bfu* zt = (bfu*)lds;
  float* outt = (float*)(lds + 62 * 256 * 2);
  __syncthreads();
#pragma unroll
  for (int it8 = 0; it8 < 8; ++it8) {
    int id = tid + 256 * it8;
    if (id >= 62 * 32) break;
    int r = id >> 5, cc = id & 31;
    int tok = t0 - 30 + r;
    uint4 o = make_uint4(0, 0, 0, 0);
    if (tok >= 0) {
      const bfu* row = proj + ((long)b * SEQ + tok) * LDP;
      uint4 a = *(const uint4*)(row + C_CA + cc * 8);
      uint4 g = *(const uint4*)(row + C_CB + cc * 8);
      o.x = pack2(lo2f(a.x) * sigmoidf_(lo2f(g.x)), hi2f(a.x) * sigmoidf_(hi2f(g.x)));
      o.y = pack2(lo2f(a.y) * sigmoidf_(lo2f(g.y)), hi2f(a.y) * sigmoidf_(hi2f(g.y)));
      o.z = pack2(lo2f(a.z) * sigmoidf_(lo2f(g.z)), hi2f(a.z) * sigmoidf_(hi2f(g.z)));
      o.w = pack2(lo2f(a.w) * sigmoidf_(lo2f(g.w)), hi2f(a.w) * sigmoidf_(hi2f(g.w)));
    }
    *(uint4*)(zt + r * 256 + cc * 8) = o;
  }
  __syncthreads();
  {
    const int c = tid;
    float w[31];
    const float* cw = p.in[12] + (long)l * 31 * 256;
#pragma unroll
    for (int j = 0; j < 31; ++j) w[j] = cw[j * 256 + c];
    const float bias = p.in[13][l * 256 + c];
    for (int tg = 0; tg < 8; ++tg) {
      float o0 = bias, o1 = bias, o2 = bias, o3 = bias;
#pragma unroll
      for (int j = 0; j < 34; ++j) {
        float z = bf2f(zt[(tg * 4 + j) * 256 + c]);
        if (j < 31) o0 += w[j < 31 ? j : 0] * z;
        if (j >= 1 && j < 32) o1 += w[(j >= 1 && j < 32) ? j - 1 : 0] * z;
        if (j >= 2 && j < 33) o2 += w[(j >= 2 && j < 33) ? j - 2 : 0] * z;
        if (j >= 3) o3 += w[j >= 3 ? j - 3 : 0] * z;
      }
      outt[(tg * 4 + 0) * 256 + c] = o0;
      outt[(tg * 4 + 1) * 256 + c] = o1;
      outt[(tg * 4 + 2) * 256 + c] = o2;
      outt[(tg * 4 + 3) * 256 + c] = o3;
    }
  }
  __syncthreads();
  {
    float4 gg = ((const float4*)(p.in[14] + l * 256))[lane];
    float4 bb = ((const float4*)(p.in[15] + l * 256))[lane];
    for (int i = 0; i < 8; ++i) {
      int tt = wid * 8 + i;
      float4 v = *(const float4*)(outt + tt * 256 + lane * 4);
      float mean = wave_sum(v.x + v.y + v.z + v.w) * (1.f / 256.f);
      float d0 = v.x - mean, d1 = v.y - mean, d2 = v.z - mean, d3 = v.w - mean;
      float var = wave_sum(d0 * d0 + d1 * d1 + d2 * d2 + d3 * d3) * (1.f / 256.f);
      float rstd = rsqrtf(var + 1e-5f);
      float r0 = d0 * rstd * gg.x + bb.x, r1 = d1 * rstd * gg.y + bb.y, r2 = d2 * rstd * gg.z + bb.z, r3 = d3 * rstd * gg.w + bb.w;
      r0 *= sigmoidf_(r0); r1 *= sigmoidf_(r1); r2 *= sigmoidf_(r2); r3 *= sigmoidf_(r3);
      uint2 o; o.x = pack2(r0, r1); o.y = pack2(r2, r3);
      *(uint2*)(y + ((long)b * SEQ + t0 + tt) * LDX + 512 + lane * 4) = o;
    }
  }
}

DEVI void prepass_item(const Params& p, int l, int idx, char* lds) {
  const bfu* proj = (const bfu*)(p.ws + OFF_PROJ);
  const int b = idx >> 5, tile = idx & 31;
  const int tid = get_tid();
  const long tok0 = (long)b * SEQ + tile * 64;
  bfu* vt = (bfu*)lds;
  __syncthreads();
#pragma unroll
  for (int i = 0; i < 8; ++i) {
    int id = tid + 256 * i;
    int tokl = id >> 5, cc = id & 31;
    int col = (cc < 16) ? (C_VS + cc * 8) : (C_VW + (cc - 16) * 8);
    uint4 u = *(const uint4*)(proj + (tok0 + tokl) * LDP + col);
    *(uint4*)(vt + tokl * 264 + cc * 8) = u;
  }
  __syncthreads();
  for (int i = 0; i < 8; ++i) {
    int id = tid + 256 * i;
    int row = id & 255, ch = id >> 8;
    unsigned short e[8];
#pragma unroll
    for (int k = 0; k < 8; ++k) e[k] = vt[(ch * 8 + k) * 264 + row];
    uint4 o;
    o.x = (unsigned)e[0] | ((unsigned)e[1] << 16); o.y = (unsigned)e[2] | ((unsigned)e[3] << 16);
    o.z = (unsigned)e[4] | ((unsigned)e[5] << 16); o.w = (unsigned)e[6] | ((unsigned)e[7] << 16);
    int which = row >> 7, hd = row & 127;
    bfu* dst = (bfu*)(p.ws + (which ? OFF_VWT : OFF_VST)) + ((long)b * 128 + hd) * SEQ + tile * 64 + ch * 8;
    *(uint4*)dst = o;
  }
}

DEVI void sconv_item(const Params& p, int l, int idx) {
  const bfu* proj = (const bfu*)(p.ws + OFF_PROJ);
  bfu* y = (bfu*)(p.ws + OFF_Y);
  const int b = idx >> 5, tile = idx & 31;
  const float* sw = p.in[16] + (long)l * 3 * 256;
#pragma unroll 2
  for (int i = 0; i < 8; ++i) {
    int id = get_tid() + 256 * i;
    int tokl = id >> 5, cc = id & 31;
    int t = tile * 64 + tokl;
    float acc[8];
#pragma unroll
    for (int e = 0; e < 8; ++e) acc[e] = 0.f;
#pragma unroll
    for (int j = 0; j < 3; ++j) {
      int ts = t - 2 + j;
      if (ts >= 0) {
        const bfu* row = proj + ((long)b * SEQ + ts) * LDP;
        uint4 a = *(const uint4*)(row + C_SC + cc * 8);
        uint4 h = *(const uint4*)(row + C_SH + cc * 8);
        const float* w = sw + j * 256 + cc * 8;
        acc[0] += w[0] * lo2f(a.x) * lo2f(h.x); acc[1] += w[1] * hi2f(a.x) * hi2f(h.x);
        acc[2] += w[2] * lo2f(a.y) * lo2f(h.y); acc[3] += w[3] * hi2f(a.y) * hi2f(h.y);
        acc[4] += w[4] * lo2f(a.z) * lo2f(h.z); acc[5] += w[5] * hi2f(a.z) * hi2f(h.z);
        acc[6] += w[6] * lo2f(a.w) * lo2f(h.w); acc[7] += w[7] * hi2f(a.w) * hi2f(h.w);
      }
    }
    uint4 bb = *(const uint4*)(proj + ((long)b * SEQ + t) * LDP + C_SB + cc * 8);
    uint4 o;
    o.x = pack2(acc[0] * lo2f(bb.x), acc[1] * hi2f(bb.x));
    o.y = pack2(acc[2] * lo2f(bb.y), acc[3] * hi2f(bb.y));
    o.z = pack2(acc[4] * lo2f(bb.z), acc[5] * hi2f(bb.z));
    o.w = pack2(acc[6] * lo2f(bb.w), acc[7] * hi2f(bb.w));
    *(uint4*)(y + ((long)b * SEQ + t) * LDX + 768 + cc * 8) = o;
  }
}

constexpr int P3_CMP = 32, P3_GMLP = 512, P3_CONF = 512, P3_PRE = 256, P3_SCONV = 256;
constexpr int P3_ITEMS = P3_CMP + P3_GMLP + P3_CONF + P3_PRE + P3_SCONV;

DEVI void pull_extras(const Params& p, int l, char* lds, volatile int* nsa_cnt, int max_pulls);
DEVI void phase3a(const Params& p, int l, char* lds, bool rep, volatile int* nsa_cnt) {
  const int v = vblk(), nv = vgrid();
  const int wg = (int)blockIdx.x, nwg = (int)gridDim.x;
  if (wg < P3_CMP) {
    for (int i = wg; i < P3_CMP; i += nwg) compress_item(p, l, i, lds);
    if (nwg > 2 * P3_CMP) return;
  }
  const bool split = (nwg > 2 * P3_CMP);
  const int first = split ? v - 2 * P3_CMP : v, step = split ? nv - 2 * P3_CMP : nv;
  for (int item = first; item < P3_PRE; item += step) prepass_item(p, l, item, lds);
  if (split && !rep) pull_extras(p, l, lds, nsa_cnt, 1);
}

constexpr float NEGF = -1e30f;

DEVI void compute_S(f32x4 (&s)[2][4], const bf16x8 (&qf)[2][2], const bfu* Ks, int fr, int fq) {
#pragma unroll
  for (int g = 0; g < 2; ++g)
#pragma unroll
    for (int k = 0; k < 4; ++k) s[g][k] = f32x4{0.f, 0.f, 0.f, 0.f};
#pragma unroll
  for (int ks = 0; ks < 2; ++ks)
#pragma unroll
    for (int ksub = 0; ksub < 4; ++ksub) {
      bf16x8 kf = *(const bf16x8*)(Ks + (ksub * 16 + fr) * LS + ks * 32 + fq * 8);
#pragma unroll
      for (int g = 0; g < 2; ++g) s[g][ksub] = __builtin_amdgcn_mfma_f32_16x16x32_bf16(kf, qf[g][ks], s[g][ksub], 0, 0, 0);
    }
}

template <bool WITH_L>
DEVI void pv_accum_t(f32x4 (&o)[2][4], f32x4 (&ol)[2], const f32x4 (&pr)[2][4], const bfu* Vt, int fr, int fq) {
#pragma unroll
  for (int kp = 0; kp < 2; ++kp) {
    bf16x8 pf[2];
#pragma unroll
    for (int g = 0; g < 2; ++g) {
      uint4 u;
      u.x = pack2(pr[g][2 * kp][0], pr[g][2 * kp][1]);
      u.y = pack2(pr[g][2 * kp][2], pr[g][2 * kp][3]);
      u.z = pack2(pr[g][2 * kp + 1][0], pr[g][2 * kp + 1][1]);
      u.w = pack2(pr[g][2 * kp + 1][2], pr[g][2 * kp + 1][3]);
      pf[g] = *(bf16x8*)&u;
    }
    if constexpr (WITH_L) {
      const short one = (fr == 0) ? (short)0x3F80 : (short)0;
      const bf16x8 vones = {one, one, one, one, one, one, one, one};
#pragma unroll
      for (int g = 0; g < 2; ++g) ol[g] = __builtin_amdgcn_mfma_f32_16x16x32_bf16(vones, pf[g], ol[g], 0, 0, 0);
    }
#pragma unroll
    for (int dsub = 0; dsub < 4; ++dsub) {
      uint2 lo = *(const uint2*)(Vt + (dsub * 16 + fr) * LS + (2 * kp) * 16 + fq * 4);
      uint2 hi = *(const uint2*)(Vt + (dsub * 16 + fr) * LS + (2 * kp + 1) * 16 + fq * 4);
      uint4 u; u.x = lo.x; u.y = lo.y; u.z = hi.x; u.w = hi.y;
      bf16x8 vf = *(bf16x8*)&u;
#pragma unroll
      for (int g = 0; g < 2; ++g) o[g][dsub] = __builtin_amdgcn_mfma_f32_16x16x32_bf16(vf, pf[g], o[g][dsub], 0, 0, 0);
    }
  }
}

DEVI void pv_accum(f32x4 (&o)[2][4], const f32x4 (&pr)[2][4], const bfu* Vt, int fr, int fq) {
  f32x4 dummy[2];
  pv_accum_t<false>(o, dummy, pr, Vt, fr, fq);
}

struct AttnState {
  f32x4 o[2][4];
  f32x4 ol[2];
  float m[2];
};

DEVI void attn_step(AttnState& st, const bf16x8 (&qf)[2][2], const bfu* Ks, const bfu* Vt, int hi, int lo, int fr, int fq) {
  const int hi4 = hi - fq * 4, lo4 = lo - fq * 4;
  f32x4 s[2][4];
  compute_S(s, qf, Ks, fr, fq);
  const bool anymask = __builtin_amdgcn_ballot_w64((hi < 63) || (lo >= 0)) != 0ull;
  if (anymask) {
#pragma unroll
    for (int g = 0; g < 2; ++g)
#pragma unroll
      for (int ksub = 0; ksub < 4; ++ksub)
#pragma unroll
        for (int j = 0; j < 4; ++j) {
          const int c = ksub * 16 + j;
          const bool v = (c <= hi4) && (c > lo4);
          s[g][ksub][j] = v ? s[g][ksub][j] : NEGF;
        }
  }
  float scs[2];
#pragma unroll
  for (int g = 0; g < 2; ++g) {
    float mx = NEGF;
#pragma unroll
    for (int ksub = 0; ksub < 4; ++ksub)
#pragma unroll
      for (int j = 0; j < 4; ++j) mx = fmaxf(mx, s[g][ksub][j]);
    mx = fmaxf(mx, __shfl_xor(mx, 16));
    mx = fmaxf(mx, __shfl_xor(mx, 32));
    float mn = fmaxf(st.m[g], mx);
    float sc = __builtin_amdgcn_exp2f(st.m[g] - mn);
#pragma unroll
    for (int ksub = 0; ksub < 4; ++ksub)
#pragma unroll
      for (int j = 0; j < 4; ++j) s[g][ksub][j] = __builtin_amdgcn_exp2f(s[g][ksub][j] - mn);
    st.m[g] = mn;
    scs[g] = sc;
  }
  if (__builtin_amdgcn_ballot_w64((scs[0] != 1.f) || (scs[1] != 1.f)) != 0ull) {
#pragma unroll
    for (int g = 0; g < 2; ++g) {
      st.ol[g] *= scs[g];
#pragma unroll
      for (int dsub = 0; dsub < 4; ++dsub) st.o[g][dsub] *= scs[g];
    }
  }
  pv_accum_t<true>(st.o, st.ol, s, Vt, fr, fq);
}

DEVI float attn_rowsum(const AttnState& st, int g) {
  float v = st.ol[g][0];
  v += __shfl_xor(v, 16);
  v += __shfl_xor(v, 32);
  return v;
}

DEVI void attn_init(AttnState& st) {
#pragma unroll
  for (int g = 0; g < 2; ++g) {
    st.m[g] = NEGF; st.ol[g] = f32x4{0.f, 0.f, 0.f, 0.f};
#pragma unroll
    for (int d = 0; d < 4; ++d) st.o[g][d] = f32x4{0.f, 0.f, 0.f, 0.f};
  }
}

DEVI void nsa_item(const Params& p, int l, int item, char* lds_raw, volatile int* nsa_cnt) {
  bfu* Kb = (bfu*)lds_raw;
  bfu* Vb = Kb + 128 * LS;
  float* Gs = (float*)(Vb + 128 * LS);
  float* Ls_ = Gs + 64 * 33;
  float* Pb = Ls_ + 64 * 33;
  unsigned* selm = (unsigned*)(Pb + 64 * 33);
  const int qt = 31 - (item >> 4), bh = item & 15, b = bh >> 1, h = bh & 1;
  const int tid = get_tid(), lane = tid & 63, wid = tid >> 6, fr = lane & 15, fq = lane >> 4;
  const bfu* proj = (const bfu*)(p.ws + OFF_PROJ);
  const long tokbase = (long)b * SEQ;
  const int t0 = qt * 64;
  const int tokl = wid * 16 + fr;
  const int mytok = t0 + tokl;
  const bfu* myrow = proj + (tokbase + mytok) * LDP;
  bf16x8 qf[2][2];
#pragma unroll
  for (int g = 0; g < 2; ++g)
#pragma unroll
    for (int ks = 0; ks < 2; ++ks) qf[g][ks] = *(const bf16x8*)(myrow + C_Q + (h * 2 + g) * 64 + ks * 32 + fq * 8);
  float gate[2][3];
#pragma unroll
  for (int g = 0; g < 2; ++g)
#pragma unroll
    for (int br = 0; br < 3; ++br) gate[g][br] = sigmoidf_(bf2f(myrow[C_NG + (h * 2 + g) * 3 + br]));
  f32x4 fin[2][4];
#pragma unroll
  for (int g = 0; g < 2; ++g)
#pragma unroll
    for (int d = 0; d < 4; ++d) fin[g][d] = f32x4{0.f, 0.f, 0.f, 0.f};

  const int ntile = (t0 + 32 >= 1024) ? 2 : 1;
  __syncthreads();
  {
    const bfu* kc = (const bfu*)(p.ws + OFF_KCMP) + (long)(b * 2 + h) * 128 * 64;
    const bfu* vc = (const bfu*)(p.ws + OFF_VCT) + (long)(b * 2 + h) * 64 * 128;
    for (int i = 0; i < 2 * ntile; ++i) {
      int id = tid + 256 * i;
      int row = id >> 3, ch = id & 7;
      *(uint4*)(Kb + row * LS + ch * 8) = *(const uint4*)(kc + row * 64 + ch * 8);
    }
    for (int i = 0; i < 2 * ntile; ++i) {
      int id = tid + 256 * i;
      int tt = id >> 9, d = (id >> 3) & 63, ch = id & 7;
      *(uint4*)(Vb + tt * 64 * LS + d * LS + ch * 8) = *(const uint4*)(vc + d * 128 + tt * 64 + ch * 8);
    }
  }
  __syncthreads();
  {
    f32x4 s[2][2][4];
    compute_S(s[0], qf, Kb, fr, fq);
    if (ntile == 2) compute_S(s[1], qf, Kb + 64 * LS, fr, fq);
    else {
#pragma unroll
      for (int g = 0; g < 2; ++g)
#pragma unroll
        for (int k = 0; k < 4; ++k) s[1][g][k] = f32x4{0.f, 0.f, 0.f, 0.f};
    }
    float inv[2];
#pragma unroll
    for (int g = 0; g < 2; ++g) {
      float mx = NEGF;
#pragma unroll
      for (int tt = 0; tt < 2; ++tt)
#pragma unroll
        for (int ksub = 0; ksub < 4; ++ksub)
#pragma unroll
          for (int j = 0; j < 4; ++j) {
            int n = tt * 64 + ksub * 16 + fq * 4 + j;
            bool v = (n * 16 + 31 <= mytok);
            float sv = v ? s[tt][g][ksub][j] : NEGF;
            s[tt][g][ksub][j] = sv;
            mx = fmaxf(mx, sv);
          }
      mx = fmaxf(mx, __shfl_xor(mx, 16));
      mx = fmaxf(mx, __shfl_xor(mx, 32));
      float ps = 0.f;
#pragma unroll
      for (int tt = 0; tt < 2; ++tt)
#pragma unroll
        for (int ksub = 0; ksub < 4; ++ksub)
#pragma unroll
          for (int j = 0; j < 4; ++j) {
            float sv = s[tt][g][ksub][j];
            float pv = (sv > -5e29f) ? __builtin_amdgcn_exp2f(sv - mx) : 0.f;
            s[tt][g][ksub][j] = pv;
            ps += pv;
          }
      ps += __shfl_xor(ps, 16);
      ps += __shfl_xor(ps, 32);
      inv[g] = ps > 0.f ? 1.f / ps : 0.f;
    }
#pragma unroll
    for (int tt = 0; tt < 2; ++tt)
#pragma unroll
      for (int ksub = 0; ksub < 4; ++ksub) {
#pragma unroll
        for (int g = 0; g < 2; ++g) s[tt][g][ksub] *= inv[g];
        float G = 0.f;
#pragma unroll
        for (int g = 0; g < 2; ++g) G += s[tt][g][ksub][0] + s[tt][g][ksub][1] + s[tt][g][ksub][2] + s[tt][g][ksub][3];
        float Lv = s[tt][0][ksub][3] + s[tt][1][ksub][3];
        int J = tt * 16 + ksub * 4 + fq;
        Gs[tokl * 33 + J] = G;
        Ls_[tokl * 33 + J] = Lv;
      }
    f32x4 o[2][4];
#pragma unroll
    for (int g = 0; g < 2; ++g)
#pragma unroll
      for (int d = 0; d < 4; ++d) o[g][d] = f32x4{0.f, 0.f, 0.f, 0.f};
    pv_accum(o, s[0], Vb, fr, fq);
    if (ntile == 2) pv_accum(o, s[1], Vb + 64 * LS, fr, fq);
#pragma unroll
    for (int g = 0; g < 2; ++g)
#pragma unroll
      for (int d = 0; d < 4; ++d) fin[g][d] += o[g][d] * gate[g][0];
  }
  __syncthreads();
  if (tid < 64) {
    const int cur = qt;
    unsigned forced = 1u | (1u << cur) | (cur > 0 ? (1u << (cur - 1)) : 0u);
    unsigned sel = forced;
    int cnt = __popc(forced);
    for (int J = 0; J < 32; ++J) {
      float v = Gs[tid * 33 + J];
      if (J > 0) v += Ls_[tid * 33 + J - 1];
      Pb[tid * 33 + J] = v;
    }
    while (cnt < 8) {
      int best = -1;
      float bv = -1.f;
      for (int J = 0; J <= cur; ++J) {
        float v = Pb[tid * 33 + J];
        if (!((sel >> J) & 1u) && v > bv) { bv = v; best = J; }
      }
      if (best < 0) break;
      sel |= 1u << best;
      ++cnt;
    }
    selm[tid] = sel;
    unsigned om = sel;
#pragma unroll
    for (int o = 32; o >= 1; o >>= 1) om |= (unsigned)__shfl_xor((int)om, o);
    if (tid == 0) selm[64] = om;
  }
  __syncthreads();
  const unsigned mysel = selm[tokl];
  const unsigned ormask = selm[64];

  uint4 rk0, rk1, rv0, rv1;
#define KV_LOAD(KB, VB, JJ)                                                           \
  do {                                                                               \
    rk0 = *(const uint4*)((KB) + (long)((JJ) * 64 + (tid >> 3)) * LDP + (tid & 7) * 8);        \
    rk1 = *(const uint4*)((KB) + (long)((JJ) * 64 + 32 + (tid >> 3)) * LDP + (tid & 7) * 8);   \
    rv0 = *(const uint4*)((VB) + (long)(tid >> 3) * SEQ + (JJ) * 64 + (tid & 7) * 8);          \
    rv1 = *(const uint4*)((VB) + (long)(32 + (tid >> 3)) * SEQ + (JJ) * 64 + (tid & 7) * 8);   \
  } while (0)
#define KV_STORE(KO)                                                       \
  do {                                                                     \
    *(uint4*)(Kb + (KO) + (tid >> 3) * LS + (tid & 7) * 8) = rk0;          \
    *(uint4*)(Kb + (KO) + (32 + (tid >> 3)) * LS + (tid & 7) * 8) = rk1;   \
    *(uint4*)(Vb + (KO) + (tid >> 3) * LS + (tid & 7) * 8) = rv0;          \
    *(uint4*)(Vb + (KO) + (32 + (tid >> 3)) * LS + (tid & 7) * 8) = rv1;   \
  } while (0)
  int kvo = 0;
  {
    AttnState st;
    attn_init(st);
    const bfu* kbase = proj + tokbase * LDP + C_KS + h * 64;
    const bfu* vbase = (const bfu*)(p.ws + OFF_VST) + ((long)b * 128 + h * 64) * SEQ;
    unsigned rem = ormask & ((2u << qt) - 1u);
    if (tid == 0) nsa_cnt[vhalf()] = __popc(rem);
    __syncthreads();
    const int niter = max(nsa_cnt[0], nsa_cnt[1]);
    int j = __ffs(rem) - 1;
    KV_LOAD(kbase, vbase, j);
    for (int itx = 0; itx < niter; ++itx) {
      const bool active = (rem != 0u);
      if (active) { j = __ffs(rem) - 1; rem &= rem - 1; }
      if (active) KV_STORE(kvo);
      __syncthreads();
      if (active) {
        if (rem) {
          int jn = __ffs(rem) - 1;
          KV_LOAD(kbase, vbase, jn);
        }
        const bool insel = (mysel >> j) & 1u;
        const int hi = insel ? ((j == qt) ? tokl : 63) : -1;
        if (__builtin_amdgcn_ballot_w64(insel) != 0ull) attn_step(st, qf, Kb + kvo, Vb + kvo, hi, -1, fr, fq);
        kvo ^= 64 * LS;
      }
    }
#pragma unroll
    for (int g = 0; g < 2; ++g) {
      const float lsum = attn_rowsum(st, g);
      float sc = (lsum > 0.f ? 1.f / lsum : 0.f) * gate[g][1];
#pragma unroll
      for (int d = 0; d < 4; ++d) fin[g][d] += st.o[g][d] * sc;
    }
  }
  {
    AttnState st;
    attn_init(st);
    const bfu* kbase = proj + tokbase * LDP + C_KW + h * 64;
    const bfu* vbase = (const bfu*)(p.ws + OFF_VWT) + ((long)b * 128 + h * 64) * SEQ;
    int j = qt - 8 < 0 ? 0 : qt - 8;
    KV_LOAD(kbase, vbase, j);
    for (; j <= qt; ++j) {
      KV_STORE(kvo);
      __syncthreads();
      if (j < qt) {
        int jn = j + 1;
        KV_LOAD(kbase, vbase, jn);
      }
      attn_step(st, qf, Kb + kvo, Vb + kvo, (j == qt) ? tokl : 63, (j == qt - 8) ? tokl : -1, fr, fq);
      kvo ^= 64 * LS;
    }
#pragma unroll
    for (int g = 0; g < 2; ++g) {
      const float lsum = attn_rowsum(st, g);
      float sc = (lsum > 0.f ? 1.f / lsum : 0.f) * gate[g][2];
#pragma unroll
      for (int d = 0; d < 4; ++d) fin[g][d] += st.o[g][d] * sc;
    }
  }
  bfu* y = (bfu*)(p.ws + OFF_Y) + (tokbase + mytok) * LDX + 256 + h * 128;
#pragma unroll
  for (int g = 0; g < 2; ++g)
#pragma unroll
    for (int d = 0; d < 4; ++d) store_bf4(y + g * 64 + d * 16 + fq * 4, fin[g][d]);
}

constexpr int P3B_EXTRA = P3_GMLP + P3_CONF + P3_SCONV;
DEVI void pull_extras(const Params& p, int l, char* lds, volatile int* nsa_cnt, int max_pulls) {
  unsigned* q = (unsigned*)(p.ws + OFF_BAR) + 3500 + l;
  for (int n = 0; n < max_pulls; ++n) {
    __syncthreads();
    if (threadIdx.x == 0) nsa_cnt[2] = (int)atomicAdd(q, 2u);
    __syncthreads();
    const int base = nsa_cnt[2];
    if (base >= P3B_EXTRA) break;
    int i = base + vhalf();
    if (i < P3_GMLP) { gmlp_item(p, l, i, lds); continue; }
    i -= P3_GMLP;
    if (i < P3_CONF) { conf_item(p, l, i, lds); continue; }
    i -= P3_CONF;
    sconv_item(p, l, i);
  }
}
DEVI void phase3b(const Params& p, int l, char* lds, volatile int* nsa_cnt) {
  for (int item = vblk(); item < 512; item += vgrid()) nsa_item(p, l, item, lds, nsa_cnt);
  pull_extras(p, l, lds, nsa_cnt, 1 << 30);
}

DEVI void phase4(const Params& p, int l, char* lds, float* p4s) {
  const bfu* xn = (const bfu*)(p.ws + OFF_XN);
  const bfu* y = (const bfu*)(p.ws + OFF_Y);
  const bfu* wg = (const bfu*)(p.ws + OFF_WGATE);
  const bfu* wb = (const bfu*)(p.ws + OFF_WBR);
  bfu* mixed = (bfu*)(p.ws + OFF_MIX);
  const float* bg = p.in[19] + (long)l * 4096;
  const int lane = get_tid512() & 63, wid = get_tid512() >> 6, wm = wid >> 1, wn = wid & 1, fr = lane & 15, fq = lane >> 4;
  GRing rg{0, 2};
  int mt, nt;
  bool have = tile_map(0, 8, mt, nt);
  for (int it = 0; have; ++it) {
    int mt2 = 0, nt2 = 0;
    const bool have2 = tile_map(it + 1, 8, mt2, nt2);
    const int m0 = mt * 256, n0 = nt * 128;
    uint2 mixp[4][4];
    {
      const int t = get_tid512();
      p4s[t] = bg[(t >> 7) * 1024 + n0 + (t & 127)];
      if (t < 256) {
        const float4 q = *(const float4*)((const float*)(p.ws + OFF_SSQA) + (long)(m0 + t) * 4);
        p4s[512 + t] = ssq_rstd((q.x + q.y) + (q.z + q.w));
      }
    }
#pragma unroll 1
    for (int bb = 0; bb < 4; ++bb) {
      f32x4 acc[4][4];
      uint2 gp[4][4];
      const GUnit ug{xn + (long)m0 * LDX, wg + ((long)bb * 1024 + n0) * LDX, LDX, LDX, 16};
      const GUnit up{y + (long)m0 * LDX + bb * 256, wb + ((long)bb * 1024 + n0) * LDBR, LDX, LDBR, 4};
      const int m0n = (bb < 3) ? m0 : mt2 * 256, n0n = (bb < 3) ? n0 : nt2 * 128, bbn = (bb < 3) ? bb + 1 : 0;
      const GUnit un{xn + (long)m0n * LDX, wg + ((long)bbn * 1024 + n0n) * LDX, LDX, LDX, 16};
      zero_acc<4>(acc);
      gemm8s<false>(acc, ug, up, true, it == 0 && bb == 0, rg, (bfu*)lds, bb > 0);
#pragma unroll
      for (int ni = 0; ni < 4; ++ni) {
        const float4 bv = *(const float4*)(p4s + bb * 128 + wn * 64 + ni * 16 + fq * 4);
#pragma unroll
        for (int mi = 0; mi < 4; ++mi) {
          const float rsm = p4s[512 + wm * 64 + mi * 16 + fr];
          gp[ni][mi].x = pack2(sigmoidf_(acc[ni][mi][0] * rsm + bv.x), sigmoidf_(acc[ni][mi][1] * rsm + bv.y));
          gp[ni][mi].y = pack2(sigmoidf_(acc[ni][mi][2] * rsm + bv.z), sigmoidf_(acc[ni][mi][3] * rsm + bv.w));
        }
      }
      zero_acc<4>(acc);
      gemm8s<false>(acc, up, un, (bb < 3) || have2, false, rg, (bfu*)lds, true);
#pragma unroll
      for (int ni = 0; ni < 4; ++ni)
#pragma unroll
        for (int mi = 0; mi < 4; ++mi) {
          float v0 = lo2f(gp[ni][mi].x) * acc[ni][mi][0];
          float v1 = hi2f(gp[ni][mi].x) * acc[ni][mi][1];
          float v2 = lo2f(gp[ni][mi].y) * acc[ni][mi][2];
          float v3 = hi2f(gp[ni][mi].y) * acc[ni][mi][3];
          if (bb > 0) {
            v0 += lo2f(mixp[ni][mi].x); v1 += hi2f(mixp[ni][mi].x);
            v2 += lo2f(mixp[ni][mi].y); v3 += hi2f(mixp[ni][mi].y);
          }
          mixp[ni][mi].x = pack2(v0, v1);
          mixp[ni][mi].y = pack2(v2, v3);
        }
    }
#pragma unroll
    for (int ni = 0; ni < 4; ++ni)
#pragma unroll
      for (int mi = 0; mi < 4; ++mi) {
        int n = n0 + wn * 64 + ni * 16 + fq * 4;
        int m = m0 + wm * 64 + mi * 16 + fr;
        *(uint2*)(mixed + (long)m * LDX + n) = mixp[ni][mi];
      }
    mt = mt2; nt = nt2; have = have2;
  }
}

DEVI void phase_resid_gemm(const Params& p, const bfu* A, int lda, int nkt, const bfu* wT, int ldb, const float* resid32,
                           float* ssq_out, float* out32, char* lds) {
  const int lane = get_tid512() & 63, wid = get_tid512() >> 6, wm = wid >> 2, wn = wid & 3, fr = lane & 15, fq = lane >> 4;
  bfu* xs = (bfu*)(p.ws + OFF_XN);
  float* part = (float*)(lds + 131072);
  int stg = 0;
  int mt, nt;
  bool have = tile_map(0, 4, mt, nt);
  for (int it = 0; have; ++it) {
    int mt2 = 0, nt2 = 0;
    const bool have2 = tile_map(it + 1, 4, mt2, nt2);
    const int m0 = mt * 256, n0 = nt * 256;
    const GUnit cur{A + (long)m0 * lda, wT + (long)n0 * ldb, lda, ldb, nkt};
    const GUnit nxt{A + (long)mt2 * 256 * lda, wT + (long)nt2 * 256 * ldb, lda, ldb, nkt};
    f32x4 acc[4][8];
    zero_acc8(acc);
    gemm16s(acc, cur, nxt, have2, it == 0, stg, (bfu*)lds);
    const int nt_cur = nt;
    mt = mt2; nt = nt2; have = have2;
#pragma unroll
    for (int mi = 0; mi < 8; ++mi) {
      const int m = m0 + wm * 128 + mi * 16 + fr;
      float ss = 0.f;
#pragma unroll
      for (int ni = 0; ni < 4; ++ni) {
        const int n = n0 + wn * 64 + ni * 16 + fq * 4;
        float4 r;
        if (resid32) r = *(const float4*)(resid32 + (long)m * 1024 + n);
        else { const uint2 u = *(const uint2*)(xs + (long)m * LDX + n); r = make_float4(lo2f(u.x), hi2f(u.x), lo2f(u.y), hi2f(u.y)); }
        float4 o;
        o.x = r.x + acc[ni][mi][0]; o.y = r.y + acc[ni][mi][1]; o.z = r.z + acc[ni][mi][2]; o.w = r.w + acc[ni][mi][3];
        if (out32) *(float4*)(out32 + (long)m * 1024 + n) = o;
        else {
          uint2 ob; ob.x = pack2(o.x, o.y); ob.y = pack2(o.z, o.w);
          *(uint2*)(xs + (long)m * LDX + n) = ob;
          const float q0 = lo2f(ob.x), q1 = hi2f(ob.x), q2 = lo2f(ob.y), q3 = hi2f(ob.y);
          ss += q0 * q0 + q1 * q1 + q2 * q2 + q3 * q3;
        }
      }
      if (!out32) {
        ss += __shfl_xor(ss, 16);
        ss += __shfl_xor(ss, 32);
        if (fq == 0) part[(wm * 128 + mi * 16 + fr) * 4 + wn] = ss;
      }
    }
    if (!out32) {
      RAW_BARRIER();
      if (get_tid512() < 256) {
        const float4 q = *(const float4*)(part + get_tid512() * 4);
        ssq_out[(long)(m0 + get_tid512()) * 4 + nt_cur] = (q.x + q.y) + (q.z + q.w);
      }
      RAW_BARRIER();
    }
  }
}

DEVI void phase7(const Params& p, int l, char* lds) {
  const bfu* hn = (const bfu*)(p.ws + OFF_XN);
  const bfu* wT = (const bfu*)(p.ws + OFF_WM1);
  bfu* hid = (bfu*)(p.ws + OFF_HID);
  const int lane = get_tid512() & 63, wid = get_tid512() >> 6, wm = wid >> 2, wn = wid & 3, fr = lane & 15, fq = lane >> 4;
  int stg = 0;
  int mt, nt;
  bool have = tile_map(0, 16, mt, nt);
  for (int it = 0; have; ++it) {
    int mt2 = 0, nt2 = 0;
    const bool have2 = tile_map(it + 1, 16, mt2, nt2);
    const int m0 = mt * 256, n0 = nt * 256;
    const GUnit cur{hn + (long)m0 * LDX, wT + (long)n0 * LDX, LDX, LDX, 16};
    const GUnit nxt{hn + (long)mt2 * 256 * LDX, wT + (long)nt2 * 256 * LDX, LDX, LDX, 16};
    const float* rsS = stage_rstd((const float*)(p.ws + OFF_SSQB), m0, it, lds);
    f32x4 acc[4][8];
    zero_acc8(acc);
    gemm16s(acc, cur, nxt, have2, it == 0, stg, (bfu*)lds);
    mt = mt2; nt = nt2; have = have2;
    float rs8[8];
#pragma unroll
    for (int mi = 0; mi < 8; ++mi) rs8[mi] = rsS[wm * 128 + mi * 16 + fr];
#pragma unroll
    for (int ni = 0; ni < 4; ++ni)
#pragma unroll
      for (int mi = 0; mi < 8; ++mi) {
        f32x4 v = acc[ni][mi];
#pragma unroll
        for (int j = 0; j < 4; ++j) { float r = fmaxf(v[j] * rs8[mi], 0.f); v[j] = r * r; }
        int n = n0 + wn * 64 + ni * 16 + fq * 4;
        int m = m0 + wm * 128 + mi * 16 + fr;
        store_bf4(hid + (long)m * LDH + n, v);
      }
  }
}

constexpr int PH_PER_LAYER = 8;
constexpr int N_PHASES = 2 * PH_PER_LAYER;

#define XB_TMO      128
#define XB_XCNT(j)  (256  + 64 * (j))
#define XB_XSUB(j)  (1280 + 64 * (j))
#define XB_XGEN(j)  (2304 + 64 * (j))
#define XB_TOP      3328
#define XB_TOPGEN   3392
#define XCD_BAR_WORDS 3456
#define XB_SPIN_CAP (1u << 20)
#define LAS __attribute__((address_space(3)))
DEVI unsigned xb_ld(unsigned* p) { return __hip_atomic_load(p, __ATOMIC_RELAXED, __HIP_MEMORY_SCOPE_AGENT); }
DEVI unsigned xb_add(unsigned* p, unsigned v) { return __hip_atomic_fetch_add(p, v, __ATOMIC_RELAXED, __HIP_MEMORY_SCOPE_AGENT); }
DEVI unsigned xb_xcc_id() { return (unsigned)__builtin_amdgcn_s_getreg((3 << 11) | 20) & 0xFu; }
#define XB_SPIN(cond, bar) do { unsigned _sp = 0; while (cond) { __builtin_amdgcn_s_sleep(1); \
    if ((++_sp & 255u) == 0u) { if (xb_ld(&(bar)[XB_TMO])) break; if (_sp > XB_SPIN_CAP) { atomicAdd(&(bar)[XB_TMO], 1u); break; } } } } while (0)
struct XcdBarrier { unsigned* bar; unsigned x; volatile LAS unsigned* st; };
DEVI XcdBarrier xcd_barrier_post(unsigned* bar, volatile LAS unsigned* st) {
  XcdBarrier b; b.bar = bar; b.x = xb_xcc_id(); b.st = st;
  if (threadIdx.x == 0) (void)xb_add(&bar[XB_XCNT(b.x)], 1u);
  return b;
}
DEVI void xcd_barrier_complete(unsigned* bar, unsigned x, unsigned& nloc, unsigned& nx) {
  const unsigned G = gridDim.x * gridDim.y * gridDim.z;
  unsigned sum, cnt, mine, sp = 0u;
  for (;;) {
    sum = 0u; cnt = 0u; mine = 0u;
#pragma unroll
    for (unsigned j = 0; j < 16; ++j) { const unsigned c = xb_ld(&bar[XB_XCNT(j)]); sum += c; cnt += (c > 0u) ? 1u : 0u; mine = (j == x) ? c : mine; }
    if (sum == G) break;
    __builtin_amdgcn_s_sleep(1);
    if ((++sp & 255u) == 0u) { if (xb_ld(&bar[XB_TMO])) break; if (sp > XB_SPIN_CAP) { atomicAdd(&bar[XB_TMO], 1u); break; } }
  }
  nloc = mine > 0u ? mine : 1u; nx = cnt > 0u ? cnt : 1u;
}
DEVI void xcd_barrier(const XcdBarrier& b) {
  asm volatile("s_waitcnt vmcnt(0)" ::: "memory");
  __syncthreads();
  if (threadIdx.x == 0) {
    unsigned* bar = b.bar;
    __builtin_amdgcn_s_waitcnt(0);
    unsigned nloc = b.st[0], nx = b.st[1];
    if (nloc == 0u) { xcd_barrier_complete(bar, b.x, nloc, nx); b.st[0] = nloc; b.st[1] = nx; }
    const unsigned old = xb_add(&bar[XB_XSUB(b.x)], 1u);
    const unsigned gen = old / nloc;
    if (old + 1u == (gen + 1u) * nloc) {
      __builtin_amdgcn_fence(__ATOMIC_RELEASE, "agent");
      asm volatile("s_waitcnt vmcnt(0)" ::: "memory");
      const unsigned og = xb_add(&bar[XB_TOP], 1u);
      const unsigned tg = og / nx;
      if (og + 1u == (tg + 1u) * nx) xb_add(&bar[XB_TOPGEN], 1u);
      else XB_SPIN(xb_ld(&bar[XB_TOPGEN]) == tg, bar);
      __builtin_amdgcn_fence(__ATOMIC_ACQUIRE, "agent");
      xb_add(&bar[XB_XGEN(b.x)], 1u);
      asm volatile("s_waitcnt vmcnt(0)" ::: "memory");
    } else {
      XB_SPIN(xb_ld(&bar[XB_XGEN(b.x)]) == gen, bar);
      __builtin_amdgcn_fence(__ATOMIC_ACQUIRE, "agent");
      asm volatile("s_waitcnt vmcnt(0)" ::: "memory");
    }
  }
  __syncthreads();
}


DEVI void run_phase(const Params& p, int ph, char* lds, volatile int* nsa_cnt, float* p4s, bool rep) {
  const int l = ph / PH_PER_LAYER, q = ph % PH_PER_LAYER;
  char* hl = lds + vhalf() * LDS_HALF;
  switch (q) {
    case 0: phase1(p, l, hl); break;
    case 1: phase2(p, l, lds); break;
    case 2: phase3a(p, l, hl, rep, nsa_cnt); break;
    case 3: phase3b(p, l, hl, nsa_cnt); break;
    case 4: phase4(p, l, lds, p4s); break;
    case 5: phase_resid_gemm(p, (const bfu*)(p.ws + OFF_MIX), LDX, 16, (const bfu*)(p.ws + OFF_WOUT), LDX,
                             (l == 0) ? p.in[0] : nullptr, (float*)(p.ws + OFF_SSQB), nullptr, lds); break;
    case 6: phase7(p, l, lds); break;
    case 7: phase_resid_gemm(p, (const bfu*)(p.ws + OFF_HID), LDH, 64, (const bfu*)(p.ws + OFF_WM2), LDH, nullptr,
                             (float*)(p.ws + OFF_SSQA), (l == 1) ? p.out : nullptr, lds); break;
  }
}

__global__ void __launch_bounds__(512, 2) fwd_mega(Params p, int ph_lo, int ph_hi, int coop) {
  extern __shared__ __attribute__((aligned(16))) char lds[];
  __shared__ uint4 xb_words;
  __shared__ int nsa_cnt_s[4];
  __shared__ float p4_stage[768];
  XcdBarrier xb;
  if (coop) {
    if (threadIdx.x == 0) xb_words = make_uint4(0u, 0u, 0u, 0u);
    __syncthreads();
    xb = xcd_barrier_post((unsigned*)(p.ws + OFF_BAR), (volatile LAS unsigned*)&xb_words);
  }
  for (int ph = ph_lo; ph < ph_hi; ++ph) {
    run_phase(p, ph, lds, nsa_cnt_s, p4_stage, false);
#ifdef REP_MASK
    if ((REP_MASK >> (ph % PH_PER_LAYER)) & 1) { xcd_barrier(xb); run_phase(p, ph, lds, nsa_cnt_s, p4_stage, true); }
#endif
#ifdef EXTRA_SYNCS
    for (int e = 0; e < EXTRA_SYNCS; ++e) xcd_barrier(xb);
#endif
    if (coop && ph + 1 < ph_hi) {
      if (coop & 2) cg::this_grid().sync();
      else xcd_barrier(xb);
    }
  }
}

extern "C" void kernel_launch(void* const* d_in, const int* in_sizes, int n_in, void* d_out, int out_size, void* d_ws,
                              size_t ws_size, hipStream_t stream) {
  static int grid_blocks = 0;
  if (!grid_blocks) {
    int dev = 0, cus = 0, per_cu = 0;
    hipGetDevice(&dev);
    hipDeviceGetAttribute(&cus, hipDeviceAttributeMultiprocessorCount, dev);
    hipFuncSetAttribute((const void*)fwd_mega, hipFuncAttributeMaxDynamicSharedMemorySize, LDS_BYTES);
    hipOccupancyMaxActiveBlocksPerMultiprocessor(&per_cu, (const void*)fwd_mega, 512, LDS_BYTES);
    if (per_cu < 1) per_cu = 1;
    if (per_cu > 1) per_cu = 1;
    grid_blocks = cus * per_cu;
    if (ws_size < WS_TOTAL) fprintf(stderr, "workspace too small: %zu < %zu\n", ws_size, (size_t)WS_TOTAL);
  }
  Params p{};
  for (int i = 0; i < 24; ++i) p.in[i] = (const float*)d_in[i];
  p.out = (float*)d_out;
  p.ws = (char*)d_ws;
#if MULTI_LAUNCH
  for (int ph = 0; ph < N_PHASES; ++ph) {
    hipLaunchKernelGGL(fwd_mega, dim3(grid_blocks), dim3(512), LDS_BYTES, stream, p, ph, ph + 1, 0);
  }
#else
  hipMemsetAsync((char*)d_ws + OFF_BAR, 0, 16384, stream);
  int lo = 0, hi = N_PHASES, coop = 1;
  void* args[] = {&p, &lo, &hi, &coop};
  hipError_t e = hipLaunchCooperativeKernel((const void*)fwd_mega, dim3(grid_blocks), dim3(512), args, LDS_BYTES, stream);
  if (e != hipSuccess) fprintf(stderr, "cooperative launch failed: %s (grid %d)\n", hipGetErrorString(e), grid_blocks);
#endif
}
```
